# Optimizing an MI355X kernel written in HIP

```python
import jax
import jax.numpy as jnp
from jax import lax
import numpy as np


D_MODEL = 4096
BATCH = 1
SEQ = 8192
DEPTH = 1

CHUNK = 64
Q_BLOCK = 128
EPS = 1e-6
D_MIX = D_MODEL
LRU_WIDTH = D_MIX // 2
LRU_BLOCKS = 16
LRU_BLOCK_DIM = LRU_WIDTH // LRU_BLOCKS
CONV_WIDTH = 4
LRU_C = 8.0
MLA_HEADS = 16
QK_NOPE_DIM = 128
QK_ROPE_DIM = 64
QK_HEAD_DIM = QK_NOPE_DIM + QK_ROPE_DIM
V_HEAD_DIM = (D_MIX - LRU_WIDTH) // MLA_HEADS
Q_LORA_RANK = 1024
KV_LORA_RANK = 512
ROPE_THETA = 10000.0
D_FF = ((8 * D_MODEL // 3 + 255) // 256) * 256
IN_SPLITS = (LRU_WIDTH, LRU_WIDTH, Q_LORA_RANK, KV_LORA_RANK, QK_ROPE_DIM)
IN_COLS = sum(IN_SPLITS)
N_MOD = 6

kernel_name = 'hybrid_rglru_mla_sandwich_adaln_block'


def rms_norm(x, g):
    xf = x.astype(jnp.float32)
    y = xf * lax.rsqrt(jnp.mean(xf * xf, axis=-1, keepdims=True) + EPS)
    return (y * g.astype(jnp.float32)).astype(x.dtype)


def split_cols(t, sizes):
    offs = np.cumsum(sizes)[:-1].tolist()
    return jnp.split(t, offs, axis=-1)


def causal_depthwise_conv(x, w, b):
    S = x.shape[1]
    xp = jnp.pad(x, ((0, 0), (CONV_WIDTH - 1, 0), (0, 0)))
    y = b
    for k in range(CONV_WIDTH):
        y = y + xp[:, k:k + S, :] * w[k]
    return y


def block_diag_linear(x, w, b):
    B, S, _ = x.shape
    xb = x.reshape(B, S, LRU_BLOCKS, LRU_BLOCK_DIM)
    return jnp.einsum('bsni,nij->bsnj', xb, w).reshape(B, S, LRU_WIDTH) + b


def rg_lru(x, w_a, b_a, w_x, b_x, lam):
    r = jax.nn.sigmoid(block_diag_linear(x, w_a, b_a).astype(jnp.float32))
    i = jax.nn.sigmoid(block_diag_linear(x, w_x, b_x).astype(jnp.float32))
    log_a = -LRU_C * r * jax.nn.softplus(-lam.astype(jnp.float32))
    a = jnp.exp(log_a)
    u = jnp.sqrt(-jnp.expm1(2.0 * log_a)) * (i * x.astype(jnp.float32))

    def combine(left, right):
        a1, b1 = left
        a2, b2 = right
        return a1 * a2, a2 * b1 + b2

    _, h = lax.associative_scan(combine, (a, u), axis=1)
    return h.astype(x.dtype)


def rope_angles(positions):
    inv_freq = ROPE_THETA ** (-jnp.arange(0, QK_ROPE_DIM, 2, dtype=jnp.float32) / QK_ROPE_DIM)
    ang = positions.astype(jnp.float32)[..., None] * inv_freq
    return jnp.cos(ang), jnp.sin(ang)


def apply_rope(x, cos, sin):
    xf = x.astype(jnp.float32)
    x1, x2 = jnp.split(xf, 2, axis=-1)
    return jnp.concatenate([x1 * cos - x2 * sin, x2 * cos + x1 * sin], axis=-1).astype(x.dtype)


def mla(q_lat, kv_lat, k_rope, positions, g_q, w_q_up, g_kv, w_kv_up):
    B, S, _ = q_lat.shape
    q = jnp.dot(rms_norm(q_lat, g_q), w_q_up).reshape(B, S, MLA_HEADS, QK_HEAD_DIM)
    q_nope, q_pe = q[..., :QK_NOPE_DIM], q[..., QK_NOPE_DIM:]
    kv = jnp.dot(rms_norm(kv_lat, g_kv), w_kv_up).reshape(B, S, MLA_HEADS, QK_NOPE_DIM + V_HEAD_DIM)
    k_nope, v = kv[..., :QK_NOPE_DIM], kv[..., QK_NOPE_DIM:]
    cos, sin = rope_angles(positions)
    q_pe = apply_rope(q_pe, cos[:, :, None, :], sin[:, :, None, :])
    k_pe = apply_rope(k_rope, cos, sin)
    scale = QK_HEAD_DIM ** -0.5
    nqb = S // Q_BLOCK
    qn = q_nope.reshape(B, nqb, Q_BLOCK, MLA_HEADS, QK_NOPE_DIM).transpose(1, 0, 2, 3, 4)
    qp = q_pe.reshape(B, nqb, Q_BLOCK, MLA_HEADS, QK_ROPE_DIM).transpose(1, 0, 2, 3, 4)
    k_chunk = jnp.arange(S) // CHUNK

    def block(args):
        qb, qn_b, qp_b = args
        s = (jnp.einsum('bqhd,bkhd->bhqk', qn_b, k_nope)
             + jnp.einsum('bqhr,bkr->bhqk', qp_b, k_pe)).astype(jnp.float32) * scale
        q_chunk = (qb * Q_BLOCK + jnp.arange(Q_BLOCK)) // CHUNK
        mask = k_chunk[None, :] <= q_chunk[:, None]
        s = jnp.where(mask[None, None], s, -jnp.inf)
        p = jax.nn.softmax(s, axis=-1)
        return jnp.einsum('bhqk,bkhd->bqhd', p.astype(v.dtype), v)

    o = lax.map(block, (jnp.arange(nqb), qn, qp))
    return o.transpose(1, 0, 2, 3, 4).reshape(B, S, MLA_HEADS * V_HEAD_DIM)


def setup_inputs(seed: int = 0) -> dict:
    key = jax.random.key(seed)
    ks = jax.random.split(key, 32)

    def nrm(k, shape, scale):
        return jax.random.normal(k, shape, jnp.float32) * scale

    def gain(k, n):
        return 1.0 + 0.02 * jax.random.normal(k, (DEPTH, n), jnp.float32)

    x = jax.random.normal(ks[0], (BATCH, SEQ, D_MODEL), jnp.float32)
    c = jax.random.normal(ks[1], (BATCH, D_MODEL), jnp.float32)
    offset = jax.random.randint(ks[2], (BATCH, 1), 0, 4096, dtype=jnp.int32)
    positions = (offset + jnp.arange(SEQ, dtype=jnp.int32)[None, :]).astype(jnp.int32)
    u = jax.random.uniform(ks[3], (DEPTH, LRU_WIDTH), jnp.float32, minval=0.9, maxval=0.999)
    s = u ** (1.0 / LRU_C)
    lru_lambda = jnp.log(s) - jnp.log1p(-s)
    return {
        'x': x,
        'c': c,
        'positions': positions,
        'w_mod': nrm(ks[4], (DEPTH, D_MODEL, N_MOD * D_MODEL), 0.5 * D_MODEL ** -0.5),
        'b_mod': nrm(ks[5], (DEPTH, N_MOD * D_MODEL), 0.02),
        'g_pre_mix': gain(ks[6], D_MODEL),
        'w_in': nrm(ks[7], (DEPTH, D_MODEL, IN_COLS), D_MODEL ** -0.5),
        'conv_w': nrm(ks[8], (DEPTH, CONV_WIDTH, LRU_WIDTH), CONV_WIDTH ** -0.5),
        'conv_b': nrm(ks[9], (DEPTH, LRU_WIDTH), 0.02),
        'lru_w_a': nrm(ks[10], (DEPTH, LRU_BLOCKS, LRU_BLOCK_DIM, LRU_BLOCK_DIM), LRU_BLOCK_DIM ** -0.5),
        'lru_b_a': nrm(ks[11], (DEPTH, LRU_WIDTH), 0.02),
        'lru_w_x': nrm(ks[12], (DEPTH, LRU_BLOCKS, LRU_BLOCK_DIM, LRU_BLOCK_DIM), LRU_BLOCK_DIM ** -0.5),
        'lru_b_x': nrm(ks[13], (DEPTH, LRU_WIDTH), 0.02),
        'lru_lambda': lru_lambda,
        'g_q_lat': gain(ks[14], Q_LORA_RANK),
        'w_q_up': nrm(ks[15], (DEPTH, Q_LORA_RANK, MLA_HEADS * QK_HEAD_DIM), Q_LORA_RANK ** -0.5),
        'g_kv_lat': gain(ks[16], KV_LORA_RANK),
        'w_kv_up': nrm(ks[17], (DEPTH, KV_LORA_RANK, MLA_HEADS * (QK_NOPE_DIM + V_HEAD_DIM)), KV_LORA_RANK ** -0.5),
        'g_lru_out': gain(ks[18], LRU_WIDTH),
        'g_mla_out': gain(ks[19], MLA_HEADS * V_HEAD_DIM),
        'w_out': nrm(ks[20], (DEPTH, D_MIX, D_MODEL), D_MIX ** -0.5),
        'g_post_mix': gain(ks[21], D_MODEL),
        'g_pre_ffn': gain(ks[22], D_MODEL),
        'w_gate': nrm(ks[23], (DEPTH, D_MODEL, D_FF), D_MODEL ** -0.5),
        'w_up': nrm(ks[24], (DEPTH, D_MODEL, D_FF), D_MODEL ** -0.5),
        'w_down': nrm(ks[25], (DEPTH, D_FF, D_MODEL), D_FF ** -0.5),
        'g_post_ffn': gain(ks[26], D_MODEL),
    }


def reference(x, c, positions, w_mod, b_mod, g_pre_mix, w_in, conv_w, conv_b, lru_w_a, lru_b_a,
              lru_w_x, lru_b_x, lru_lambda, g_q_lat, w_q_up, g_kv_lat, w_kv_up, g_lru_out, g_mla_out,
              w_out, g_post_mix, g_pre_ffn, w_gate, w_up, w_down, g_post_ffn):
    for l in range(DEPTH):
        mod = jnp.dot(jax.nn.silu(c), w_mod[l]) + b_mod[l]
        sh_a, sc_a, gt_a, sh_f, sc_f, gt_f = [m[:, None, :] for m in jnp.split(mod, N_MOD, axis=-1)]

        h = rms_norm(x, g_pre_mix[l]) * (1.0 + sc_a) + sh_a
        proj = jnp.dot(h, w_in[l])
        xr, gr, q_lat, kv_lat, k_rope = split_cols(proj, IN_SPLITS)
        xr = causal_depthwise_conv(xr, conv_w[l], conv_b[l])
        y_lru = rg_lru(xr, lru_w_a[l], lru_b_a[l], lru_w_x[l], lru_b_x[l], lru_lambda[l]) * jax.nn.gelu(gr)
        y_mla = mla(q_lat, kv_lat, k_rope, positions, g_q_lat[l], w_q_up[l], g_kv_lat[l], w_kv_up[l])
        y = jnp.concatenate([rms_norm(y_lru, g_lru_out[l]), rms_norm(y_mla, g_mla_out[l])], axis=-1)
        y = jnp.dot(y, w_out[l])
        x = x + gt_a * rms_norm(y, g_post_mix[l])

        h = rms_norm(x, g_pre_ffn[l]) * (1.0 + sc_f) + sh_f
        f = jnp.dot(jax.nn.silu(jnp.dot(h, w_gate[l])) * jnp.dot(h, w_up[l]), w_down[l])
        x = x + gt_f * rms_norm(f, g_post_ffn[l])
    return x
```

```cpp
#include <hip/hip_runtime.h>
#include <cstdio>
#include <cstdint>

#ifndef LAUNCH_LIST
#define LAUNCH_LIST {0, 12}
#endif

#define LAS __attribute__((address_space(3)))
#define GAS __attribute__((address_space(1)))
typedef unsigned short bf16_t;
typedef short bf16x8 __attribute__((ext_vector_type(8)));
typedef float f32x4 __attribute__((ext_vector_type(4)));
typedef float f32x2 __attribute__((ext_vector_type(2)));
typedef float f32x16 __attribute__((ext_vector_type(16)));
typedef unsigned u32x4 __attribute__((ext_vector_type(4)));
typedef unsigned u32x2 __attribute__((ext_vector_type(2)));
typedef short s16x4 __attribute__((ext_vector_type(4)));

constexpr int S_ = 8192, DM = 4096, NIN = 5696, NINP = 5888, LRUW = 2048, QL = 1024, KVL = 512, ROPE = 64;
constexpr int NH = 16, NOPE = 128, VD = 128, DFF = 11008, NGU = 2 * DFF, NMOD = 6 * DM;
constexpr int COL_GR = 2048, COL_QL = 4096, COL_KVL = 5120, COL_KR = 5632;
constexpr int LDK = DM + 64;
constexpr float EPS = 1e-6f;
constexpr float QSCALE = 0.07216878364870322f * 1.4426950408889634f;

__device__ __forceinline__ unsigned cvt_pk_bf16(float lo, float hi) { unsigned r; asm volatile("v_cvt_pk_bf16_f32 %0, %1, %2" : "=v"(r) : "v"(lo), "v"(hi)); return r; }
__device__ __forceinline__ float bflo(unsigned w) { return __uint_as_float(w << 16); }
__device__ __forceinline__ float bfhi(unsigned w) { return __uint_as_float(w & 0xffff0000u); }
__device__ __forceinline__ float bf1(bf16_t b) { return __uint_as_float((unsigned)b << 16); }
__device__ __forceinline__ float wave_sum(float v) {
#pragma unroll
    for (int o = 1; o < 64; o <<= 1) v += __shfl_xor(v, o);
    return v;
}
__device__ __forceinline__ float sigmoidf_(float z) { return 1.0f / (1.0f + __expf(-z)); }
__device__ __forceinline__ float gelu_tanh(float x) { const float z = 0.7978845608028654f * (x + 0.044715f * x * x * x); const float t = 1.0f - 2.0f / (1.0f + __expf(2.0f * z)); return 0.5f * x * (1.0f + t); }

__device__ __forceinline__ void glds16(const void* sbase, unsigned voff, unsigned lds_dst) {
    unsigned keep;
    asm volatile("s_mov_b32 %0, m0\n\ts_mov_b32 m0, %3\n\ts_nop 0\n\tglobal_load_lds_dwordx4 %1, %2\n\ts_mov_b32 m0, %0" : "=&s"(keep) : "v"(voff), "s"(sbase), "s"(lds_dst) : "memory");
}
namespace pg8 {
constexpr int BM = 256, BK = 64, HALF = 128, HTB = HALF * BK * 2, STAGE_BYTES = 8 * HTB, NXCD = 8, WGM = 8;
__host__ __device__ __forceinline__ int lds_byte(int r, int c) { const int st = (r >> 4) * 2 + (c >> 5), rr = r & 15, cc = c & 31, ob = rr * 64 + cc * 2; return st * 1024 + (ob ^ (((ob >> 9) & 1) << 5)); }
__host__ __device__ __forceinline__ void stage_rc(int b, int& R, int& C) { const int st = b / 1024, sb = b % 1024, swz = sb ^ (((sb >> 9) & 1) << 5); R = (st >> 1) * 16 + swz / 64; C = (st & 1) * 32 + (swz % 64) / 2; }
__host__ __device__ __forceinline__ int perm32(int rho) { const int n = rho >> 4, i = rho & 15; return 8 * (i >> 2) + 4 * n + (i & 3); }
struct Unit { int pm, pn; };
struct Gemm { const bf16_t* A; const bf16_t* Bt; int M, N, K, lda, ldb; };
struct StaticOrder {
    int nM, nN, nwg, G, c;
    __host__ __device__ void init(int M, int N, int G_, int c_) { nM = M / BM; nN = N / BM; nwg = nM * nN; G = G_; c = c_; }
    __host__ __device__ bool next(int i, Unit& u) const {
        const long L = (long)i * G + c; if (L >= nwg) return false;
        int wgid = (int)L; { const int q = nwg / NXCD, r = nwg % NXCD, xcd = wgid % NXCD, off = wgid / NXCD; wgid = (xcd < r ? xcd * (q + 1) : r * (q + 1) + (xcd - r) * q) + off; }
        const int nig = WGM * nN, gid = wgid / nig, fm = gid * WGM, gsz = (nM - fm) < WGM ? (nM - fm) : WGM;
        u.pm = fm + ((wgid % nig) % gsz); u.pn = (wgid % nig) / gsz; return true;
    }
    __device__ __forceinline__ void a_ready(const Unit&) const {}
    __device__ __forceinline__ void done(const Unit&) const {}
};

template <class Epi, class Sched, bool ALIGN_EPI>
__device__ __forceinline__ void gemm_phase(LAS unsigned char* lds, const Gemm g, const Sched& S, const Epi& E) {
    const int tid = threadIdx.x, wid = __builtin_amdgcn_readfirstlane(tid >> 6), lane = tid & 63, wr = wid >> 2, wc = wid & 3, fr = lane & 15, fq = lane >> 4;
    const int K = g.K, nt = K / BK;
    unsigned voffA[2], voffB[2];
#pragma unroll
    for (int i = 0; i < 2; ++i) { int R, C; stage_rc(tid * 16 + i * 8192, R, C); const int Rb = (R & ~31) + perm32(R & 31);
        voffA[i] = (unsigned)(R * g.lda + C) * 2u; voffB[i] = (unsigned)(Rb * g.ldb + C) * 2u; }
    const size_t kstep = (size_t)(BK * 2);
    const size_t hstepA = (size_t)HALF * g.lda * 2, hstepB = (size_t)HALF * g.ldb * 2;
    const size_t tstepA = 2 * hstepA, tstepB = 2 * hstepB;
    const unsigned ldsw = (unsigned)wid * 1024u;
    const int aoff = lds_byte(wr * 64 + fr, fq * 8), boff = lds_byte(wc * 32 + fr, fq * 8);
#define PG8_SA(b, h) (((b) * 2 + (h)) * HTB)
#define PG8_SB(b, h) ((4 + (b) * 2 + (h)) * HTB)
#define PG8_STAGE(bufoff, gbase, voff) do { _Pragma("unroll") for (int _i = 0; _i < 2; ++_i) \
        __builtin_amdgcn_global_load_lds((const unsigned*)((const char*)(gbase) + (voff)[_i]), (LAS unsigned*)(lds + (bufoff) + ldsw + _i * 8192), 16, 0, 0); } while (0)
#define PG8_LDA(dst, b, h) do { _Pragma("unroll") for (int m = 0; m < 4; ++m) _Pragma("unroll") for (int k = 0; k < 2; ++k) dst[m][k] = *(const LAS bf16x8*)(lds + PG8_SA(b, h) + aoff + m * 2048 + k * 1024); } while (0)
#define PG8_LDB(dst, b, h) do { _Pragma("unroll") for (int n = 0; n < 2; ++n) _Pragma("unroll") for (int k = 0; k < 2; ++k) dst[n][k] = *(const LAS bf16x8*)(lds + PG8_SB(b, h) + boff + n * 2048 + k * 1024); } while (0)
#define PG8_MMA(ai, bj, At, Bt) do { __builtin_amdgcn_s_setprio(1); _Pragma("unroll") for (int m = 0; m < 4; ++m) _Pragma("unroll") for (int n = 0; n < 2; ++n) _Pragma("unroll") for (int k = 0; k < 2; ++k) \
        acc[ai][bj][m][n] = __builtin_amdgcn_mfma_f32_16x16x32_bf16(Bt[n][k], At[m][k], acc[ai][bj][m][n], 0, 0, 0); __builtin_amdgcn_s_setprio(0); } while (0)
#define PG8_WAIT_V(n) asm volatile("s_waitcnt vmcnt(" #n ")" ::: "memory")
#define PG8_WAIT_L(n) asm volatile("s_waitcnt lgkmcnt(" #n ")" ::: "memory")
#define PG8_BAR __builtin_amdgcn_s_barrier()
#define PG8_SCHED __builtin_amdgcn_sched_barrier(0)
    Unit cur, nxt; int ui = 0;
    if (!S.next(0, cur)) return;
    f32x4 acc[2][2][4][2];
#pragma unroll
    for (int a = 0; a < 2; ++a)
#pragma unroll
        for (int b = 0; b < 2; ++b)
#pragma unroll
            for (int m = 0; m < 4; ++m)
#pragma unroll
                for (int n = 0; n < 2; ++n) acc[a][b][m][n] = (f32x4){0.f, 0.f, 0.f, 0.f};
    bf16x8 At[4][2], B0[2][2], B1[2][2];
    const char* cA = (const char*)g.A + (size_t)cur.pm * tstepA; const char* cB = (const char*)g.Bt + (size_t)cur.pn * tstepB;
    S.a_ready(cur);
    PG8_STAGE(PG8_SB(0, 0), cB, voffB); PG8_STAGE(PG8_SB(0, 1), cB + hstepB, voffB); PG8_STAGE(PG8_SA(0, 0), cA, voffA); PG8_STAGE(PG8_SA(0, 1), cA + hstepA, voffA);
    if (wr == 1) PG8_BAR;
    PG8_WAIT_V(2); PG8_BAR;
    PG8_STAGE(PG8_SB(1, 0), cB + kstep, voffB); PG8_STAGE(PG8_SA(1, 0), cA + kstep, voffA); PG8_STAGE(PG8_SB(1, 1), cB + hstepB + kstep, voffB);
    PG8_WAIT_V(6); PG8_BAR;
    for (;;) {
        const bool has_next = S.next(ui + 1, nxt);
        const char* nA = has_next ? (const char*)g.A + (size_t)nxt.pm * tstepA : cA; const char* nB = has_next ? (const char*)g.Bt + (size_t)nxt.pn * tstepB : cB;
        for (int t = 0; t < nt; t += 2) {
            const bool last = (t == nt - 2);
            const char* a1 = cA + (size_t)(t + 1) * kstep;
            const char* a2 = last ? nA : cA + (size_t)(t + 2) * kstep; const char* b2 = last ? nB : cB + (size_t)(t + 2) * kstep;
            const char* a3 = a2 + kstep; const char* b3 = b2 + kstep;
            if (last && has_next) S.a_ready(nxt);
            PG8_LDB(B0, 0, 0); PG8_LDB(B1, 0, 1); PG8_SCHED; PG8_LDA(At, 0, 0); PG8_STAGE(PG8_SA(1, 1), a1 + hstepA, voffA);
            PG8_WAIT_V(8); PG8_WAIT_L(0); PG8_BAR; PG8_MMA(0, 0, At, B0); PG8_MMA(0, 1, At, B1); PG8_BAR; PG8_SCHED;
            PG8_LDA(At, 0, 1); PG8_STAGE(PG8_SB(0, 0), b2, voffB); PG8_STAGE(PG8_SB(0, 1), b2 + hstepB, voffB); PG8_STAGE(PG8_SA(0, 0), a2, voffA);
            PG8_WAIT_V(8); PG8_WAIT_L(0); PG8_BAR; PG8_MMA(1, 0, At, B0); PG8_MMA(1, 1, At, B1); PG8_BAR; PG8_SCHED;
            PG8_LDB(B0, 1, 0); PG8_LDB(B1, 1, 1); PG8_SCHED; PG8_LDA(At, 1, 0); PG8_STAGE(PG8_SA(0, 1), a2 + hstepA, voffA);
            PG8_WAIT_V(8); PG8_WAIT_L(0); PG8_BAR; PG8_MMA(0, 0, At, B0); PG8_MMA(0, 1, At, B1); PG8_BAR; PG8_SCHED;
            PG8_LDA(At, 1, 1); PG8_STAGE(PG8_SB(1, 0), b3, voffB); PG8_STAGE(PG8_SB(1, 1), b3 + hstepB, voffB); PG8_STAGE(PG8_SA(1, 0), a3, voffA);
            PG8_WAIT_V(8); PG8_WAIT_L(0); PG8_BAR; PG8_MMA(1, 0, At, B0); PG8_MMA(1, 1, At, B1); PG8_BAR; PG8_SCHED;
        }
        if constexpr (ALIGN_EPI) { if (wr == 0) PG8_BAR; }
        E(acc, cur, wr, wc, fr, fq); S.done(cur);
        if (!has_next) break;
#pragma unroll
        for (int a = 0; a < 2; ++a)
#pragma unroll
            for (int b = 0; b < 2; ++b)
#pragma unroll
                for (int m = 0; m < 4; ++m)
#pragma unroll
                    for (int n = 0; n < 2; ++n) acc[a][b][m][n] = (f32x4){0.f, 0.f, 0.f, 0.f};
        cur = nxt; cA = nA; cB = nB; ++ui;
        if constexpr (ALIGN_EPI) { if (wr == 1) PG8_BAR; }
    }
    PG8_WAIT_V(0);
    if constexpr (!ALIGN_EPI) { if (wr == 0) PG8_BAR; }
    PG8_BAR;
#undef PG8_SA
#undef PG8_SB
#undef PG8_STAGE
#undef PG8_LDA
#undef PG8_LDB
#undef PG8_MMA
#undef PG8_WAIT_V
#undef PG8_WAIT_L
#undef PG8_BAR
#undef PG8_SCHED
}

struct EpiStore {
    bf16_t* O; int ldc;
    __device__ __forceinline__ void operator()(const f32x4 (&acc)[2][2][4][2], const Unit& u, int wr, int wc, int fr, int fq) const {
        const int row0 = u.pm * BM + wr * 64 + fr, col0 = u.pn * BM + wc * 32 + 8 * fq;
#pragma unroll
        for (int ai = 0; ai < 2; ++ai)
#pragma unroll
            for (int m = 0; m < 4; ++m) { bf16_t* rowp = O + (size_t)(row0 + ai * HALF + m * 16) * ldc + col0;
#pragma unroll
                for (int bj = 0; bj < 2; ++bj) { const f32x4 v0 = acc[ai][bj][m][0], v1 = acc[ai][bj][m][1];
                    u32x4 w; w.x = cvt_pk_bf16(v0[0], v0[1]); w.y = cvt_pk_bf16(v0[2], v0[3]); w.z = cvt_pk_bf16(v1[0], v1[1]); w.w = cvt_pk_bf16(v1[2], v1[3]);
                    *(u32x4*)(rowp + bj * HALF) = w; } }
    }
};
struct EpiKV {
    bf16_t* KT; bf16_t* VT; const float* rs;
    __device__ __forceinline__ void operator()(const f32x4 (&acc)[2][2][4][2], const Unit& u, int wr, int wc, int fr, int fq) const {
        const int row0 = u.pm * BM + wr * 64 + fr;
#pragma unroll
        for (int ai = 0; ai < 2; ++ai)
#pragma unroll
            for (int m = 0; m < 4; ++m) { const int row = row0 + ai * HALF + m * 16; const float s = rs[row];
                const int tile = row >> 6, k = row & 63; const size_t tb = ((size_t)u.pn * 128 + tile) * 8192;
                { const f32x4 v0 = acc[ai][0][m][0] * s, v1 = acc[ai][0][m][1] * s;
                  u32x4 w; w.x = cvt_pk_bf16(v0[0], v0[1]); w.y = cvt_pk_bf16(v0[2], v0[3]); w.z = cvt_pk_bf16(v1[0], v1[1]); w.w = cvt_pk_bf16(v1[2], v1[3]);
                  *(u32x4*)(KT + tb + (4 * wc + fq) * 512 + k * 8) = w; }
                { const f32x4 v0 = acc[ai][1][m][0] * s, v1 = acc[ai][1][m][1] * s;
                  u32x4 w; w.x = cvt_pk_bf16(v0[0], v0[1]); w.y = cvt_pk_bf16(v0[2], v0[3]); w.z = cvt_pk_bf16(v1[0], v1[1]); w.w = cvt_pk_bf16(v1[2], v1[3]);
                  const int kk = (k & ~0xC) | ((k & 4) << 1) | ((k & 8) >> 1), c0 = 32 * wc + 8 * fq;
                  *(u32x4*)(VT + tb + ((kk >> 3) * 4 + (c0 >> 5)) * 256 + (kk & 7) * 32 + (c0 & 31)) = w; } }
    }
};
struct EpiQ {
    bf16_t* QN; bf16_t* QPE; const float* rs; const f32x2* cs;
    __device__ __forceinline__ void operator()(const f32x4 (&acc)[2][2][4][2], const Unit& u, int wr, int wc, int fr, int fq) const {
        const int row0 = u.pm * BM + wr * 64 + fr;
        if (u.pn < 8) {
            const int col0 = u.pn * BM + wc * 32 + 8 * fq;
#pragma unroll
            for (int ai = 0; ai < 2; ++ai)
#pragma unroll
                for (int m = 0; m < 4; ++m) { const int row = row0 + ai * HALF + m * 16; const float s = rs[row] * QSCALE; bf16_t* rowp = QN + (size_t)row * 2048 + col0;
#pragma unroll
                    for (int bj = 0; bj < 2; ++bj) { const f32x4 v0 = acc[ai][bj][m][0] * s, v1 = acc[ai][bj][m][1] * s;
                        u32x4 w; w.x = cvt_pk_bf16(v0[0], v0[1]); w.y = cvt_pk_bf16(v0[2], v0[3]); w.z = cvt_pk_bf16(v1[0], v1[1]); w.w = cvt_pk_bf16(v1[2], v1[3]);
                        *(u32x4*)(rowp + bj * HALF) = w; } }
        } else {
            const int head = 4 * (u.pn - 8) + wc, j0 = 8 * fq;
#pragma unroll
            for (int ai = 0; ai < 2; ++ai)
#pragma unroll
                for (int m = 0; m < 4; ++m) { const int row = row0 + ai * HALF + m * 16; const float s = rs[row] * QSCALE;
                    const f32x4* cp = (const f32x4*)(cs + (size_t)row * 32 + j0);
                    float o1[8], o2[8];
#pragma unroll
                    for (int q = 0; q < 4; ++q) { const f32x4 c2 = cp[q];
                        const int n = q >> 1, e = (q & 1) * 2;
                        const float x1a = acc[ai][0][m][n][e] * s, x2a = acc[ai][1][m][n][e] * s, x1b = acc[ai][0][m][n][e + 1] * s, x2b = acc[ai][1][m][n][e + 1] * s;
                        o1[2 * q] = x1a * c2[0] - x2a * c2[1]; o2[2 * q] = x2a * c2[0] + x1a * c2[1];
                        o1[2 * q + 1] = x1b * c2[2] - x2b * c2[3]; o2[2 * q + 1] = x2b * c2[2] + x1b * c2[3]; }
                    bf16_t* rowp = QPE + (size_t)row * 1024 + head * 64 + j0;
                    u32x4 w1, w2; w1.x = cvt_pk_bf16(o1[0], o1[1]); w1.y = cvt_pk_bf16(o1[2], o1[3]); w1.z = cvt_pk_bf16(o1[4], o1[5]); w1.w = cvt_pk_bf16(o1[6], o1[7]);
                    w2.x = cvt_pk_bf16(o2[0], o2[1]); w2.y = cvt_pk_bf16(o2[2], o2[3]); w2.z = cvt_pk_bf16(o2[4], o2[5]); w2.w = cvt_pk_bf16(o2[6], o2[7]);
                    *(u32x4*)rowp = w1; *(u32x4*)(rowp + 32) = w2; }
        }
    }
};
struct EpiGU {
    bf16_t* H;
    __device__ __forceinline__ void operator()(const f32x4 (&acc)[2][2][4][2], const Unit& u, int wr, int wc, int fr, int fq) const {
        const int row0 = u.pm * BM + wr * 64 + fr, col0 = u.pn * HALF + wc * 32 + 8 * fq;
#pragma unroll
        for (int ai = 0; ai < 2; ++ai)
#pragma unroll
            for (int m = 0; m < 4; ++m) { bf16_t* rowp = H + (size_t)(row0 + ai * HALF + m * 16) * DFF + col0;
                float h[8];
#pragma unroll
                for (int n = 0; n < 2; ++n)
#pragma unroll
                    for (int e = 0; e < 4; ++e) { const float gv = acc[ai][0][m][n][e], uv = acc[ai][1][m][n][e]; h[4 * n + e] = gv * __builtin_amdgcn_rcpf(1.0f + __expf(-gv)) * uv; }
                u32x4 w; w.x = cvt_pk_bf16(h[0], h[1]); w.y = cvt_pk_bf16(h[2], h[3]); w.z = cvt_pk_bf16(h[4], h[5]); w.w = cvt_pk_bf16(h[6], h[7]);
                *(u32x4*)rowp = w; }
    }
};
}

constexpr size_t MiB = 1u << 20;
constexpr size_t WS_CTL = 0, CTL_ZERO_BYTES = 1 * MiB;
constexpr size_t WS_MODP = 1 * MiB;
constexpr size_t WS_MOD = 3 * MiB;
constexpr size_t WS_CS = 4 * MiB;
constexpr size_t WS_RSQ = 6 * MiB;
constexpr size_t WS_RSKV = 6 * MiB + 65536;
constexpr size_t WS_RS1 = 6 * MiB + 131072;
constexpr size_t WS_CA = 7 * MiB;
constexpr size_t WS_CH = 7 * MiB + 512 * 1024;
constexpr size_t WS_WIN = 1100 * MiB;
constexpr size_t WS_WQ = 54 * MiB;
constexpr size_t WS_WKV = 60 * MiB;
constexpr size_t WS_WG = 64 * MiB;
constexpr size_t WS_WOUT = 1148 * MiB;
constexpr size_t WS_WGU = 1182 * MiB;
constexpr size_t WS_WDN = 270 * MiB;
constexpr size_t WS_XN = 1358 * MiB;
constexpr size_t WS_PROJ = 420 * MiB;
constexpr size_t WS_XC = 512 * MiB;
constexpr size_t WS_QN = 544 * MiB;
constexpr size_t WS_QPE = 576 * MiB;
constexpr size_t WS_KT = 592 * MiB;
constexpr size_t WS_VT = 624 * MiB;
constexpr size_t WS_KPE = 656 * MiB;
constexpr size_t WS_HLOC = 658 * MiB;
constexpr size_t WS_PP = 690 * MiB;
constexpr size_t WS_Y = 1424 * MiB;
constexpr size_t WS_YO = 786 * MiB;
constexpr size_t WS_H = 850 * MiB;
constexpr size_t WS_F = 1022 * MiB;
constexpr size_t WS_END = 1490 * MiB;
constexpr int CW_BAR = 4096;

constexpr int RING_OFF = 0, RING_BYTES = 131072;
constexpr int FILL_OFF = 131072;
constexpr int LDS_BYTES = 163840;
constexpr int LDSCTL_OFF = 135168;
constexpr int NWAVES = 8;

#define LDS_WAIT() asm volatile("s_waitcnt lgkmcnt(0)" ::: "memory")
#define VM_WAIT() asm volatile("s_waitcnt vmcnt(0)" ::: "memory")

#define XB_TMO      128
#define XB_XCNT(j)  (256  + 64 * (j))
#define XB_XSUB(j)  (1280 + 64 * (j))
#define XB_XGEN(j)  (2304 + 64 * (j))
#define XB_TOP      3328
#define XB_TOPGEN   3392
#define XCD_BAR_WORDS 3456
#define XB_SPIN_CAP (1u << 18)
__device__ __forceinline__ unsigned xb_ld(unsigned* p)              { return __hip_atomic_load(p, __ATOMIC_RELAXED, __HIP_MEMORY_SCOPE_AGENT); }
__device__ __forceinline__ unsigned xb_add(unsigned* p, unsigned v) { return __hip_atomic_fetch_add(p, v, __ATOMIC_RELAXED, __HIP_MEMORY_SCOPE_AGENT); }
__device__ __forceinline__ unsigned xb_xcc_id() { return (unsigned)__builtin_amdgcn_s_getreg((3 << 11) | 20) & 0xFu; }
#define XB_SPIN(cond, bar) do { unsigned _sp = 0; while (cond) { __builtin_amdgcn_s_sleep(1); \
    if ((++_sp & 255u) == 0u) { if (xb_ld(&(bar)[XB_TMO])) break; if (_sp > XB_SPIN_CAP) { atomicAdd(&(bar)[XB_TMO], 1u); break; } } } } while (0)
struct XcdBarrier { unsigned* bar; unsigned x; unsigned* st; };
__device__ __forceinline__ XcdBarrier xcd_barrier_post(unsigned* bar, unsigned* st) {
    XcdBarrier b; b.bar = bar; b.x = xb_xcc_id(); b.st = st;
    if (threadIdx.x == 0) (void)xb_add(&bar[XB_XCNT(b.x)], 1u);
    return b;
}
__device__ __forceinline__ void xcd_barrier_complete(unsigned* bar, unsigned x, unsigned& nloc, unsigned& nx) {
    const unsigned G = gridDim.x * gridDim.y * gridDim.z;
    unsigned sum, cnt, mine, sp = 0u;
    for (;;) {
        sum = 0u; cnt = 0u; mine = 0u;
#pragma unroll
        for (unsigned j = 0; j < 16; ++j) { const unsigned c = xb_ld(&bar[XB_XCNT(j)]); sum += c; cnt += (c > 0u) ? 1u : 0u; mine = (j == x) ? c : mine; }
        if (sum == G) break;
        __builtin_amdgcn_s_sleep(1);
        if ((++sp & 255u) == 0u) { if (xb_ld(&bar[XB_TMO])) break; if (sp > XB_SPIN_CAP) { atomicAdd(&bar[XB_TMO], 1u); break; } }
    }
    nloc = mine > 0u ? mine : 1u; nx = cnt > 0u ? cnt : 1u;
}
__device__ __forceinline__ void xcd_barrier(const XcdBarrier& b) {
    asm volatile("s_waitcnt vmcnt(0)" ::: "memory");
    __syncthreads();
    if (threadIdx.x == 0) {
        unsigned* bar = b.bar;
        __builtin_amdgcn_s_waitcnt(0);
        unsigned nloc = xb_ld(&b.st[0]), nx = xb_ld(&b.st[1]);
        if (nloc == 0u) { xcd_barrier_complete(bar, b.x, nloc, nx); __hip_atomic_store(&b.st[0], nloc, __ATOMIC_RELAXED, __HIP_MEMORY_SCOPE_AGENT); __hip_atomic_store(&b.st[1], nx, __ATOMIC_RELAXED, __HIP_MEMORY_SCOPE_AGENT); }
        const unsigned old = xb_add(&bar[XB_XSUB(b.x)], 1u);
        const unsigned gen = old / nloc;
        if (old + 1u == (gen + 1u) * nloc) {
            __builtin_amdgcn_fence(__ATOMIC_RELEASE, "agent");
            asm volatile("s_waitcnt vmcnt(0)" ::: "memory");
            const unsigned og = xb_add(&bar[XB_TOP], 1u);
            const unsigned tg = og / nx;
            if (og + 1u == (tg + 1u) * nx) xb_add(&bar[XB_TOPGEN], 1u);
            else XB_SPIN(xb_ld(&bar[XB_TOPGEN]) == tg, bar);
            __builtin_amdgcn_fence(__ATOMIC_ACQUIRE, "agent");
            xb_add(&bar[XB_XGEN(b.x)], 1u);
            asm volatile("s_waitcnt vmcnt(0)" ::: "memory");
        } else {
            XB_SPIN(xb_ld(&bar[XB_XGEN(b.x)]) == gen, bar);
            __builtin_amdgcn_fence(__ATOMIC_ACQUIRE, "agent");
            asm volatile("s_waitcnt vmcnt(0)" ::: "memory");
        }
    }
    __syncthreads();
}

struct Frame {
    LAS unsigned char* lds;
    int wave, vcu, G;
    float* out;
    unsigned char* ws;
};
#define WSP(T, off) ((T*)(F.ws + (off)))
__device__ __forceinline__ int lane_id() { return (int)__builtin_amdgcn_mbcnt_hi(~0u, __builtin_amdgcn_mbcnt_lo(~0u, 0u)); }
template <int OFF> __device__ __forceinline__ const float* arg_ptr() {
    unsigned long long p; const unsigned long long k = (unsigned long long)__builtin_amdgcn_kernarg_segment_ptr();
    asm volatile("s_load_dwordx2 %0, %1, %2\n\ts_waitcnt lgkmcnt(0)" : "=s"(p) : "s"(k), "i"(OFF));
    return (const float*)p;
}
#define INP(i) arg_ptr<8 * (i)>()

constexpr int WGU_KB_P0A = 46;
struct TrIt { const float* src; bf16_t* dst; const float* ks; int ldw, K; };
__device__ __forceinline__ void tr_load(const TrIt& t, f32x4 (&v)[8], int lane) {
    const int kr = lane >> 3, c4 = lane & 7;
#pragma unroll
    for (int i = 0; i < 8; ++i) v[i] = __builtin_nontemporal_load((const GAS f32x4*)(t.src + (size_t)(kr + 8 * i) * t.ldw + 4 * c4));
}
__device__ __forceinline__ void tr_put(const TrIt& t, f32x4 (&v)[8], LAS float* scr, int lane) {
    const int kr = lane >> 3, c4 = lane & 7;
    if (t.ks) {
#pragma unroll
        for (int i = 0; i < 8; ++i) v[i] *= t.ks[kr + 8 * i];
    }
#pragma unroll
    for (int i = 0; i < 8; ++i) { LAS float* d = scr + (kr + 8 * i) * 33 + 4 * c4; d[0] = v[i][0]; d[1] = v[i][1]; d[2] = v[i][2]; d[3] = v[i][3]; }
    LDS_WAIT(); asm volatile("" ::: "memory");
    const int c = lane & 7;
#pragma unroll
    for (int j = 0; j < 4; ++j) { const int n = (lane >> 3) + 8 * j; const LAS float* s = scr + (8 * c) * 33 + n;
        u32x4 o; o.x = cvt_pk_bf16(s[0 * 33], s[1 * 33]); o.y = cvt_pk_bf16(s[2 * 33], s[3 * 33]); o.z = cvt_pk_bf16(s[4 * 33], s[5 * 33]); o.w = cvt_pk_bf16(s[6 * 33], s[7 * 33]);
        *(GAS u32x4*)(t.dst + (size_t)n * t.K + 8 * c) = o; }
    LDS_WAIT(); asm volatile("" ::: "memory");
}
__device__ __forceinline__ TrIt tr_mk(const float* W, int ldw, int c0, bf16_t* WT, int K, int n0, int k0, const float* kscale) {
    TrIt t; t.src = W + (size_t)k0 * ldw + c0; t.dst = WT + (size_t)n0 * K + k0; t.ks = kscale ? kscale + k0 : nullptr; t.ldw = ldw; t.K = K; return t; }
__device__ __forceinline__ TrIt tr_plain(const float* W, int N, bf16_t* WT, int K, int r) { const int nnb = N / 32, nb = r % nnb, kb = r / nnb; return tr_mk(W, N, nb * 32, WT, K, nb * 32, kb * 64, nullptr); }
#define TR_RUN(DECODE, first, stride, count, scr) do { const int ln_ = lane_id(); f32x4 va_[8], vb_[8]; TrIt cur_, nxt_; int r_ = (first); \
        if (r_ < (count)) { { const int r = r_; cur_ = (DECODE); } tr_load(cur_, va_, ln_); } \
        for (; r_ < (count); r_ += (stride)) { const bool hn_ = r_ + (stride) < (count); \
            if (hn_) { { const int r = r_ + (stride); nxt_ = (DECODE); } tr_load(nxt_, vb_, ln_); } \
            tr_put(cur_, va_, (scr), ln_); \
            if (hn_) { cur_ = nxt_; _Pragma("unroll") for (int i_ = 0; i_ < 8; ++i_) va_[i_] = vb_[i_]; } } } while (0)
__device__ __forceinline__ TrIt wgu_item(const float* wg, const float* wu, bf16_t* WT, int r, int kb0) {
    const int nb = r % 688, kb = kb0 + r / 688, t = nb >> 3, q = nb & 7;
    return tr_mk((q < 4) ? wg : wu, DFF, t * 128 + (q & 3) * 32, WT, LDK, nb * 32, kb * 64, nullptr); }
__device__ __forceinline__ TrIt p0a_decode(Frame& F, int r) {
    constexpr int I_WIN = (NIN / 32) * (DM / 64), I_WQ = 96 * (QL / 64), I_WKV = 128 * (KVL / 64), I_WGU = (NGU / 32) * WGU_KB_P0A;
    if (r < I_WIN) return tr_plain(INP(6), NIN, WSP(bf16_t, WS_WIN), LDK, r);
    r -= I_WIN;
    if (r < I_WQ) { const int nb = r % 96, kb = r / 96; int src;
        if (nb < 64) src = (nb >> 2) * 192 + (nb & 3) * 32; else { const int q = nb - 64, T = q >> 3, half = (q >> 2) & 1, hh = q & 3; src = (4 * T + hh) * 192 + 128 + half * 32; }
        return tr_mk(INP(15), NH * 192, src, WSP(bf16_t, WS_WQ), QL, nb * 32, kb * 64, INP(14)); }
    r -= I_WQ;
    if (r < I_WKV) { const int nb = r % 128, kb = r / 128; return tr_mk(INP(17), NH * 256, nb * 32, WSP(bf16_t, WS_WKV), KVL, nb * 32, kb * 64, INP(16)); }
    r -= I_WKV;
    if (r < I_WGU) return wgu_item(INP(23), INP(24), WSP(bf16_t, WS_WGU), r, 0);
    r -= I_WGU;
    { const int kb = r & 1, jb = (r >> 1) & 3, gate = (r >> 3) & 1, n = r >> 4;
      return tr_mk((gate ? INP(11) : INP(9)) + (size_t)n * 16384, 128, jb * 32, WSP(bf16_t, WS_WG) + (size_t)(n * 256 + gate * 128) * 128, 128, jb * 32, kb * 64, nullptr); }
}
__device__ __forceinline__ void p0a_prep(Frame& F) {
    LAS float* scr = (LAS float*)(F.lds + RING_OFF + F.wave * 16384);
    const int gw = F.vcu * NWAVES + F.wave, NGW = F.G * NWAVES;
    {
        const float* cvec = INP(1); const GAS f32x4* W4 = (const GAS f32x4*)INP(3); f32x4* MP = WSP(f32x4, WS_MODP);
        for (int task = gw; task < 96 * 16; task += NGW) {
            const int cg = task % 96, ks = task / 96;
            f32x4 acc = (f32x4){0.f, 0.f, 0.f, 0.f};
            const GAS f32x4* wp = W4 + (size_t)(ks * 256) * (NMOD / 4) + cg * 64 + lane_id();
#pragma unroll 8
            for (int k = 0; k < 256; ++k) { const float cv = cvec[ks * 256 + k]; const float sv = cv / (1.0f + __expf(-cv)); acc += __builtin_nontemporal_load(wp + (size_t)k * (NMOD / 4)) * sv; }
            MP[(size_t)ks * (NMOD / 4) + cg * 64 + lane_id()] = acc;
        }
    }
    {
        const int* pos = (const int*)INP(2); f32x2* CS = WSP(f32x2, WS_CS);
        for (int idx = gw * 64 + lane_id(); idx < S_ * 32; idx += NGW * 64) {
            const int t = idx >> 5, j = idx & 31;
            const float inv = (float)exp(-(double)j * (9.210340371976184 / 32.0));
            const float ang = (float)pos[t] * inv;
            const double rev = (double)ang * 0.15915494309189535; const double fr = rev - rint(rev);
            const float frf = (float)fr;
            CS[idx] = (f32x2){__builtin_amdgcn_cosf(frf), __builtin_amdgcn_sinf(frf)};
        }
    }
    constexpr int NITEMS = (NIN / 32) * (DM / 64) + 96 * (QL / 64) + 128 * (KVL / 64) + (NGU / 32) * WGU_KB_P0A + 16 * 2 * 4 * 2;
    TR_RUN(p0a_decode(F, r), gw, NGW, NITEMS, scr);
}

__device__ __forceinline__ float mod_col(const float* MP, const float* bmod, int col) {
    float s = bmod[col];
#pragma unroll
    for (int ks = 0; ks < 16; ++ks) s += MP[(size_t)ks * NMOD + col];
    return s;
}
__device__ __forceinline__ void p0b_xn(Frame& F) {
    const float* MP = WSP(float, WS_MODP); const float* bmod = INP(4);
    LAS float* cA = (LAS float*)(F.lds + RING_OFF); LAS float* cB = cA + DM;
    for (int ch = (F.wave * 64 + lane_id()); ch < DM; ch += NWAVES * 64) { const float sh = mod_col(MP, bmod, ch), sc = mod_col(MP, bmod, DM + ch); cA[ch] = INP(5)[ch] * (1.0f + sc); cB[ch] = sh; }
    { float* MOD = WSP(float, WS_MOD); for (int i = blockIdx.x * (NWAVES * 64) + (F.wave * 64 + lane_id()); i < NMOD; i += F.G * NWAVES * 64) MOD[i] = mod_col(MP, bmod, i); }
    __syncthreads();
    const int gw = F.vcu * NWAVES + F.wave, NGW = F.G * NWAVES;
    for (int row = gw; row < S_; row += NGW) {
        const GAS f32x4* xr = (const GAS f32x4*)(INP(0) + (size_t)row * DM) + lane_id();
        f32x4 v[16]; float s = 0.f;
#pragma unroll
        for (int j = 0; j < 16; ++j) { v[j] = xr[64 * j]; s += (v[j][0] * v[j][0] + v[j][1] * v[j][1]) + (v[j][2] * v[j][2] + v[j][3] * v[j][3]); }
        const float rstd = 1.0f / sqrtf(wave_sum(s) * (1.0f / DM) + EPS);
        u32x2* o8 = (u32x2*)(WSP(bf16_t, WS_XN) + (size_t)row * LDK) + lane_id();
#pragma unroll
        for (int j = 0; j < 16; ++j) { const f32x4 a = *(const LAS f32x4*)(cA + 4 * (lane_id() + 64 * j)), b = *(const LAS f32x4*)(cB + 4 * (lane_id() + 64 * j));
            const f32x4 h = v[j] * rstd * a + b; u32x2 w; w.x = cvt_pk_bf16(h[0], h[1]); w.y = cvt_pk_bf16(h[2], h[3]); o8[64 * j] = w; }
    }
    __syncthreads();
}

__device__ __forceinline__ void p2_thin(Frame& F) {
    const int gw = F.vcu * NWAVES + F.wave, NGW = F.G * NWAVES;
    const bf16_t* PROJ = WSP(bf16_t, WS_PROJ);
    for (int row = gw; row < S_; row += NGW) {
        const bf16_t* pr = PROJ + (size_t)row * NINP;
        { const u32x4* q = (const u32x4*)(pr + COL_QL) + 2 * lane_id(); float s = 0.f;
#pragma unroll
          for (int i = 0; i < 2; ++i) { const u32x4 w = q[i];
#pragma unroll
            for (int e = 0; e < 4; ++e) { const float a = bflo(w[e]), b = bfhi(w[e]); s += a * a + b * b; } }
          s = wave_sum(s); if (lane_id() == 0) WSP(float, WS_RSQ)[row] = 1.0f / sqrtf(s * (1.0f / QL) + EPS); }
        { const u32x4 w = ((const u32x4*)(pr + COL_KVL))[lane_id()]; float s = 0.f;
#pragma unroll
          for (int e = 0; e < 4; ++e) { const float a = bflo(w[e]), b = bfhi(w[e]); s += a * a + b * b; }
          s = wave_sum(s); if (lane_id() == 0) WSP(float, WS_RSKV)[row] = 1.0f / sqrtf(s * (1.0f / KVL) + EPS); }
        if (lane_id() < 32) { const float x1 = bf1(pr[COL_KR + lane_id()]), x2 = bf1(pr[COL_KR + 32 + lane_id()]); const f32x2 c = WSP(f32x2, WS_CS)[(size_t)row * 32 + lane_id()];
            bf16_t* kp = WSP(bf16_t, WS_KPE) + (size_t)(row >> 6) * 4096 + (row & 63) * 8; const int d = lane_id();
            kp[(d >> 3) * 512 + (d & 7)] = (bf16_t)(cvt_pk_bf16(x1 * c[0] - x2 * c[1], 0.f) & 0xffffu); kp[((32 + d) >> 3) * 512 + (d & 7)] = (bf16_t)(cvt_pk_bf16(x2 * c[0] + x1 * c[1], 0.f) & 0xffffu); }
    }
    const float* cw = INP(7); const float* cb = INP(8);
    for (int item = gw * 64 + lane_id(); item < (S_ / 16) * (LRUW / 8); item += NGW * 64) {
        const int t0 = (item >> 8) * 16, ch0 = (item & 255) * 8;
        const GAS bf16_t* xp = (const GAS bf16_t*)PROJ + (size_t)t0 * NINP + ch0;
        u32x4 xr[19];
#pragma unroll
        for (int i = 0; i < 19; ++i) xr[i] = (t0 - 3 + i >= 0) ? *(const GAS u32x4*)(xp + (ptrdiff_t)(i - 3) * NINP) : (u32x4){0u, 0u, 0u, 0u};
        f32x4 wq[4][2], bq[2];
#pragma unroll
        for (int k = 0; k < 4; ++k) { wq[k][0] = *(const f32x4*)(cw + k * LRUW + ch0); wq[k][1] = *(const f32x4*)(cw + k * LRUW + ch0 + 4); }
        bq[0] = *(const f32x4*)(cb + ch0); bq[1] = *(const f32x4*)(cb + ch0 + 4);
        GAS bf16_t* op = (GAS bf16_t*)WSP(bf16_t, WS_XC) + (size_t)t0 * LRUW + ch0;
#pragma unroll
        for (int i = 0; i < 16; ++i) { f32x4 a0 = bq[0], a1 = bq[1];
#pragma unroll
            for (int k = 0; k < 4; ++k) { const u32x4 w = xr[i + k];
                a0 += wq[k][0] * (f32x4){bflo(w[0]), bfhi(w[0]), bflo(w[1]), bfhi(w[1])}; a1 += wq[k][1] * (f32x4){bflo(w[2]), bfhi(w[2]), bflo(w[3]), bfhi(w[3])}; }
            u32x4 o; o.x = cvt_pk_bf16(a0[0], a0[1]); o.y = cvt_pk_bf16(a0[2], a0[3]); o.z = cvt_pk_bf16(a1[0], a1[1]); o.w = cvt_pk_bf16(a1[2], a1[3]);
            *(GAS u32x4*)(op + (size_t)i * LRUW) = o; }
    }
}

__device__ __forceinline__ int crow(int r, int hi) { return (r & 3) + 8 * (r >> 2) + 4 * hi; }
__device__ __forceinline__ void lru_task(Frame& F, int task) {
    const int lane = lane_id(), r32 = lane & 31, hi = lane >> 5;
    const int cg = task & 3, n = (task >> 2) & 15, chunk = task >> 6;
    const int ch = n * 128 + cg * 32 + r32;
    const bf16_t* WG = WSP(bf16_t, WS_WG) + (size_t)n * 256 * 128;
    bf16x8 Ba[8], Bx[8];
#pragma unroll
    for (int ks = 0; ks < 8; ++ks) { Ba[ks] = *(const bf16x8*)(WG + (size_t)(cg * 32 + r32) * 128 + ks * 16 + hi * 8); Bx[ks] = *(const bf16x8*)(WG + (size_t)(128 + cg * 32 + r32) * 128 + ks * 16 + hi * 8); }
    const float ba = INP(10)[ch], bx = INP(12)[ch];
    const float lam = INP(13)[ch];
    const float nsp8 = -8.0f * log1pf(__expf(-lam));
    bf16_t* HL = WSP(bf16_t, WS_HLOC); bf16_t* PPo = WSP(bf16_t, WS_PP);
    float Sst = 0.f, Qst = 1.f;
    bf16x8 E0, E1;
#pragma unroll
    for (int j = 0; j < 8; ++j) { E0[j] = (8 * hi + j == r32) ? (short)0x3F80 : (short)0; E1[j] = (16 + 8 * hi + j == r32) ? (short)0x3F80 : (short)0; }
    const GAS char* xcb = (const GAS char*)(WSP(bf16_t, WS_XC) + (size_t)chunk * 256 * LRUW + n * 128);
    const unsigned xlo = (unsigned)(r32 * LRUW + hi * 8) * 2u;
    bf16x8 A[8], An[8];
#pragma unroll
    for (int ks = 0; ks < 8; ++ks) A[ks] = *(const GAS bf16x8*)(xcb + xlo + ks * 32);
    for (int ti = 0; ti < 8; ++ti) {
        const int t0 = chunk * 256 + ti * 32;
        if (ti + 1 < 8) {
#pragma unroll
            for (int ks = 0; ks < 8; ++ks) An[ks] = *(const GAS bf16x8*)(xcb + (size_t)(ti + 1) * (32 * LRUW * 2) + xlo + ks * 32);
        }
        f32x16 aa = {}, ax = {}, xt = {};
#pragma unroll
        for (int ks = 0; ks < 8; ++ks) { aa = __builtin_amdgcn_mfma_f32_32x32x16_bf16(A[ks], Ba[ks], aa, 0, 0, 0); ax = __builtin_amdgcn_mfma_f32_32x32x16_bf16(A[ks], Bx[ks], ax, 0, 0, 0); }
        { const bf16x8 xa0 = (cg == 0) ? A[0] : (cg == 1) ? A[2] : (cg == 2) ? A[4] : A[6], xa1 = (cg == 0) ? A[1] : (cg == 1) ? A[3] : (cg == 2) ? A[5] : A[7];
          xt = __builtin_amdgcn_mfma_f32_32x32x16_bf16(xa0, E0, xt, 0, 0, 0); xt = __builtin_amdgcn_mfma_f32_32x32x16_bf16(xa1, E1, xt, 0, 0, 0); }
        float av[16], uv[16];
#pragma unroll
        for (int r = 0; r < 16; ++r) {
            const float xv = xt[r];
            const float rg = sigmoidf_(aa[r] + ba), ig = sigmoidf_(ax[r] + bx);
            const float la = nsp8 * rg, x2 = 2.0f * la;
            av[r] = __expf(la);
            const float poly = -x2 * (1.0f + x2 * (0.5f + x2 * (0.16666667f + x2 * (0.041666668f + x2 * (0.0083333338f + x2 * 0.0013888889f)))));
            const float om = (x2 > -0.25f) ? poly : (1.0f - __expf(x2));
            uv[r] = __builtin_amdgcn_sqrtf(om) * (ig * xv);
        }
        float Pg[4], Hg[4];
#pragma unroll
        for (int g = 0; g < 4; ++g) { float P = 1.f, Hh = 0.f;
#pragma unroll
            for (int i = 0; i < 4; ++i) { const int r = 4 * g + i; Hh = av[r] * Hh + uv[r]; P *= av[r]; uv[r] = Hh; av[r] = P; }
            Pg[g] = P; Hg[g] = Hh; }
#pragma unroll
        for (int g = 0; g < 4; ++g) {
            const float Po = __shfl_xor(Pg[g], 32), Ho = __shfl_xor(Hg[g], 32);
            const float P0 = hi ? Po : Pg[g], H0 = hi ? Ho : Hg[g], P1 = hi ? Pg[g] : Po, H1 = hi ? Hg[g] : Ho;
            const float S0 = Sst, Q0 = Qst; Sst = P0 * Sst + H0; Qst = Qst * P0;
            const float S1 = Sst, Q1 = Qst; Sst = P1 * Sst + H1; Qst = Qst * P1;
            const float cS = hi ? S1 : S0, cQ = hi ? Q1 : Q0;
#pragma unroll
            for (int i = 0; i < 4; ++i) { const int r = 4 * g + i; const size_t o = (size_t)(t0 + crow(r, hi)) * LRUW + ch;
                HL[o] = (bf16_t)(cvt_pk_bf16(uv[r] + av[r] * cS, 0.f) & 0xffffu); PPo[o] = (bf16_t)(cvt_pk_bf16(av[r] * cQ, 0.f) & 0xffffu); }
        }
#pragma unroll
        for (int ks = 0; ks < 8; ++ks) A[ks] = An[ks];
    }
    if (hi == 0) { WSP(float, WS_CA)[chunk * LRUW + ch] = Qst; WSP(float, WS_CH)[chunk * LRUW + ch] = Sst; }
}

#define KSLOT 24576
#define VSLOT 16384
constexpr int ATT_K0 = 0, ATT_V0 = 2 * KSLOT, ATT_WS = 2 * KSLOT + 3 * VSLOT, ATT_QPE = ATT_WS + NWAVES * 256, ATT_LDS = ATT_QPE + NWAVES * 4096;
static_assert(ATT_LDS <= LDSCTL_OFF, "attention LDS");
__device__ __forceinline__ int v_rd_base(int lane) { return ((lane & 3) << 3) | (((lane >> 2) & 3) << 6) | (((lane >> 4) & 1) << 5) | (((lane >> 5) & 1) << 8); }
constexpr int v_rd_off(int d0, int ks, int half) { return d0 * 512 + ks * 4096 + half * 2048; }
template <int OFF> __device__ __forceinline__ s16x4 tr_read(int vb) { s16x4 r; asm volatile("ds_read_b64_tr_b16 %0, %1 offset:%2" : "=&v"(r) : "v"(vb), "i"(OFF) : "memory"); return r; }
__device__ __forceinline__ void glds16s(const void* sbase, unsigned voff, unsigned lds_dst) {
    unsigned keep;
    asm volatile("s_mov_b32 %0, m0\n\ts_mov_b32 m0, %3\n\ts_nop 0\n\tglobal_load_lds_dwordx4 %1, %2\n\ts_mov_b32 m0, %0" : "=&s"(keep) : "v"(voff), "s"(sbase), "s"(lds_dst) : "memory");
}
struct VFr { s16x4 l0, h0, l1, h1, l2, h2, l3, h3; };
template <int D0> __device__ __forceinline__ void v_rd(VFr& f, int vb) {
    f.l0 = tr_read<v_rd_off(D0, 0, 0)>(vb); f.h0 = tr_read<v_rd_off(D0, 0, 1)>(vb); f.l1 = tr_read<v_rd_off(D0, 1, 0)>(vb); f.h1 = tr_read<v_rd_off(D0, 1, 1)>(vb);
    f.l2 = tr_read<v_rd_off(D0, 2, 0)>(vb); f.h2 = tr_read<v_rd_off(D0, 2, 1)>(vb); f.l3 = tr_read<v_rd_off(D0, 3, 0)>(vb); f.h3 = tr_read<v_rd_off(D0, 3, 1)>(vb);
}
__device__ __forceinline__ void v_mma(f32x16& od, const VFr& f, bf16x8 pa0, bf16x8 pa1, bf16x8 pa2, bf16x8 pa3) {
#define PK(L, H) (bf16x8){L[0], L[1], L[2], L[3], H[0], H[1], H[2], H[3]}
    od = __builtin_amdgcn_mfma_f32_32x32x16_bf16(pa0, PK(f.l0, f.h0), od, 0, 0, 0);
    od = __builtin_amdgcn_mfma_f32_32x32x16_bf16(pa1, PK(f.l1, f.h1), od, 0, 0, 0);
    od = __builtin_amdgcn_mfma_f32_32x32x16_bf16(pa2, PK(f.l2, f.h2), od, 0, 0, 0);
    od = __builtin_amdgcn_mfma_f32_32x32x16_bf16(pa3, PK(f.l3, f.h3), od, 0, 0, 0);
#undef PK
}
__device__ __forceinline__ void pv_tile(f32x16 (&o)[4], int vb, bf16x8 pa0, bf16x8 pa1, bf16x8 pa2, bf16x8 pa3) {
    VFr fa, fb;
    v_rd<0>(fa, vb); v_rd<1>(fb, vb);
    asm volatile("s_waitcnt lgkmcnt(8)" ::: "memory"); __builtin_amdgcn_sched_barrier(0);
    v_mma(o[0], fa, pa0, pa1, pa2, pa3); __builtin_amdgcn_sched_barrier(0);
    v_rd<2>(fa, vb);
    asm volatile("s_waitcnt lgkmcnt(8)" ::: "memory"); __builtin_amdgcn_sched_barrier(0);
    v_mma(o[1], fb, pa0, pa1, pa2, pa3); __builtin_amdgcn_sched_barrier(0);
    v_rd<3>(fb, vb);
    asm volatile("s_waitcnt lgkmcnt(8)" ::: "memory"); __builtin_amdgcn_sched_barrier(0);
    v_mma(o[2], fa, pa0, pa1, pa2, pa3); __builtin_amdgcn_sched_barrier(0);
    asm volatile("s_waitcnt lgkmcnt(0)" ::: "memory"); __builtin_amdgcn_sched_barrier(0);
    v_mma(o[3], fb, pa0, pa1, pa2, pa3); __builtin_amdgcn_sched_barrier(0);
}
__device__ __forceinline__ void attn_unit(Frame& F, int h, int qb) {
    const int lane = lane_id(), wid = F.wave, r32 = lane & 31, hi = lane >> 5;
    const bool lag = wid >= 4;
    const bf16_t* QN = WSP(bf16_t, WS_QN); const bf16_t* QPE = WSP(bf16_t, WS_QPE);
    LAS unsigned char* lds = F.lds + RING_OFF;
    LAS float* wsf = (LAS float*)(lds + ATT_WS) + wid * 64;
    const int q0 = qb * 256 + wid * 32;
    const int NT = 4 * qb + 4, my_nt = 4 * qb + (wid >> 1) + 1;
    const char* ktb0 = (const char*)WSP(bf16_t, WS_KT) + (size_t)h * (128 * 16384) + wid * 1024;
    const char* vtb0 = (const char*)WSP(bf16_t, WS_VT) + (size_t)h * (128 * 16384) + wid * 1024;
    const char* kpb0 = (const char*)WSP(bf16_t, WS_KPE) + wid * 1024;
    const unsigned lo16 = (unsigned)lane * 16u;
    const unsigned ldsK = (unsigned)(uintptr_t)(lds + ATT_K0), ldsV = (unsigned)(uintptr_t)(lds + ATT_V0);
#define ATT_DMA1(p, tile, kslot, vslot) do { \
        if ((p) == 0) glds16s(ktb0 + (size_t)(tile) * 16384, lo16, ldsK + (kslot) * KSLOT + wid * 1024); \
        if ((p) == 1) glds16s(ktb0 + (size_t)(tile) * 16384 + 8192, lo16, ldsK + (kslot) * KSLOT + wid * 1024 + 8192); \
        if ((p) == 2) glds16s(kpb0 + (size_t)(tile) * 8192, lo16, ldsK + (kslot) * KSLOT + wid * 1024 + 16384); \
        if ((p) == 3) glds16s(vtb0 + (size_t)(tile) * 16384, lo16, ldsV + (vslot) * VSLOT + wid * 1024); \
        if ((p) == 4) glds16s(vtb0 + (size_t)(tile) * 16384 + 8192, lo16, ldsV + (vslot) * VSLOT + wid * 1024 + 8192); } while (0)
#define ATT_DMA(tile, kslot, vslot) do { ATT_DMA1(0, tile, kslot, vslot); ATT_DMA1(1, tile, kslot, vslot); ATT_DMA1(2, tile, kslot, vslot); ATT_DMA1(3, tile, kslot, vslot); ATT_DMA1(4, tile, kslot, vslot); } while (0)
    asm volatile("s_waitcnt lgkmcnt(0)" ::: "memory"); __builtin_amdgcn_s_barrier(); asm volatile("" ::: "memory");
    ATT_DMA(0, 0, 0);
    bf16x8 qr[8];
#pragma unroll
    for (int d0 = 0; d0 < 8; ++d0) qr[d0] = *(const bf16x8*)(QN + (size_t)(q0 + r32) * 2048 + h * 128 + d0 * 16 + hi * 8);
    LAS unsigned char* qpl = lds + ATT_QPE + wid * 4096 + lane * 16;
#pragma unroll
    for (int d0 = 0; d0 < 4; ++d0) *(LAS bf16x8*)(qpl + d0 * 1024) = *(const bf16x8*)(QPE + (size_t)(q0 + r32) * 1024 + h * 64 + d0 * 16 + hi * 8);
    f32x16 o[4] = {}; float m_reg = -1e30f, l_reg = 0.f;
    bf16x8 pa0 = {}, pa1 = {}, pa2 = {}, pa3 = {};
    const int vbase = (int)(uintptr_t)(lds + ATT_V0) + v_rd_base(lane);
    int vs_cur = 0, vs_prev = 0;
    for (int j = 0; j < NT; ++j) {
        asm volatile("s_waitcnt vmcnt(0)" ::: "memory"); __builtin_amdgcn_s_barrier(); asm volatile("" ::: "memory");
        const int vs_next = (vs_cur == 2 * VSLOT) ? 0 : vs_cur + VSLOT;
        const int vsl = (vs_next == 0) ? 0 : (vs_next == VSLOT ? 1 : 2); const bool pre = (j + 1 < NT);
        if (pre && j >= my_nt) ATT_DMA(j + 1, (j + 1) & 1, vsl);
        if (lag && j >= 1 && j - 1 < my_nt) pv_tile(o, vbase + vs_prev, pa0, pa1, pa2, pa3);
        if (j < my_nt) {
            f32x16 p0 = {}, p1 = {};
            const LAS unsigned char* kb = lds + ATT_K0 + (j & 1) * KSLOT + hi * 1024 + r32 * 16;
            bf16x8 kf[4][2], qpf[4];
#define KLD(s) do { kf[(s) & 3][0] = *(const LAS bf16x8*)(kb + (s) * 2048); kf[(s) & 3][1] = *(const LAS bf16x8*)(kb + (s) * 2048 + 512); } while (0)
            __builtin_amdgcn_sched_barrier(0);
            KLD(0); KLD(1); KLD(2); KLD(3);
            __builtin_amdgcn_sched_barrier(0);
#pragma unroll
            for (int s = 0; s < 12; ++s) {
                if (s == 4) {
#pragma unroll
                    for (int d = 0; d < 4; ++d) qpf[d] = *(const LAS bf16x8*)(qpl + d * 1024);
                }
                const bf16x8 qf = (s < 8) ? qr[s & 7] : qpf[s & 3];
                p0 = __builtin_amdgcn_mfma_f32_32x32x16_bf16(kf[s & 3][0], qf, p0, 0, 0, 0); p1 = __builtin_amdgcn_mfma_f32_32x32x16_bf16(kf[s & 3][1], qf, p1, 0, 0, 0);
                __builtin_amdgcn_sched_barrier(0);
                if (s + 4 < 12) KLD(s + 4);
                if (pre && (s & 1) == 1 && s < 10) ATT_DMA1(s >> 1, j + 1, (j + 1) & 1, vsl);
                __builtin_amdgcn_sched_barrier(0);
            }
#undef KLD
            float mx = fmaxf(p0[0], p1[0]);
#pragma unroll
            for (int r = 1; r < 16; ++r) mx = fmaxf(fmaxf(mx, p0[r]), p1[r]);
            { auto rr = __builtin_amdgcn_permlane32_swap(__float_as_uint(mx), __float_as_uint(mx), false, false); mx = fmaxf(__uint_as_float(rr[0]), __uint_as_float(rr[1])); }
            if (__any(mx - m_reg > 8.0f)) {
                const float mn = fmaxf(m_reg, mx); const float alpha = __builtin_amdgcn_exp2f(m_reg - mn); m_reg = mn; l_reg *= alpha;
                if (hi == 0) wsf[r32] = alpha; asm volatile("s_waitcnt lgkmcnt(0)" ::: "memory");
#pragma unroll
                for (int d = 0; d < 4; ++d)
#pragma unroll
                    for (int r = 0; r < 16; ++r) o[d][r] *= wsf[crow(r, hi)];
            }
            float ps = 0.f;
#pragma unroll
            for (int r = 0; r < 16; ++r) { p0[r] = __builtin_amdgcn_exp2f(p0[r] - m_reg); p1[r] = __builtin_amdgcn_exp2f(p1[r] - m_reg); ps += p0[r] + p1[r]; }
            { auto rr = __builtin_amdgcn_permlane32_swap(__float_as_uint(ps), __float_as_uint(ps), false, false); ps = __uint_as_float(rr[0]) + __uint_as_float(rr[1]); }
            l_reg += ps;
#define PK4(P, BASE, OUT) do { unsigned a0 = cvt_pk_bf16(P[BASE + 0], P[BASE + 1]), a1 = cvt_pk_bf16(P[BASE + 2], P[BASE + 3]);   \
    unsigned b0_ = cvt_pk_bf16(P[BASE + 4], P[BASE + 5]), b1_ = cvt_pk_bf16(P[BASE + 6], P[BASE + 7]);                              \
    auto r0 = __builtin_amdgcn_permlane32_swap(a0, b0_, false, false); auto r1 = __builtin_amdgcn_permlane32_swap(a1, b1_, false, false); \
    u32x4 w = {r0[0], r1[0], r0[1], r1[1]}; OUT = __builtin_bit_cast(bf16x8, w); } while (0)
            PK4(p0, 0, pa0); PK4(p0, 8, pa1); PK4(p1, 0, pa2); PK4(p1, 8, pa3);
#undef PK4
            if (!lag) pv_tile(o, vbase + vs_cur, pa0, pa1, pa2, pa3);
        }
        vs_prev = vs_cur; vs_cur = vs_next;
    }
    if (lag && NT - 1 < my_nt) pv_tile(o, vbase + vs_prev, pa0, pa1, pa2, pa3);
    if (hi == 0) wsf[32 + r32] = l_reg;
    asm volatile("s_waitcnt lgkmcnt(0)" ::: "memory");
    bf16_t* Yo = WSP(bf16_t, WS_Y) + (size_t)q0 * LDK + LRUW + h * 128;
#pragma unroll
    for (int r = 0; r < 16; ++r) { const int orow = crow(r, hi); const float rl = __builtin_amdgcn_rcpf(wsf[32 + orow]);
#pragma unroll
        for (int d0 = 0; d0 < 4; ++d0) Yo[(size_t)orow * LDK + d0 * 32 + r32] = (bf16_t)(cvt_pk_bf16(o[d0][r] * rl, 0.f) & 0xffffu); }
#undef ATT_DMA
#undef ATT_DMA1
}
__device__ __forceinline__ void attn_phase(Frame& F) {
    for (int uidx = F.vcu; uidx < 256; uidx += F.G) {
        const int h = uidx >> 4, s = uidx & 15;
        attn_unit(F, h, s);
        attn_unit(F, h, 31 - s);
    }
    asm volatile("s_waitcnt vmcnt(0) lgkmcnt(0)" ::: "memory"); __builtin_amdgcn_s_barrier();
}

__device__ __forceinline__ void p5_finalize(Frame& F) {
    LAS float* carry = (LAS float*)(F.lds + RING_OFF);
    const float* CA = WSP(float, WS_CA); const float* CH = WSP(float, WS_CH);
    const bf16_t* HL = WSP(bf16_t, WS_HLOC); const bf16_t* PPi = WSP(bf16_t, WS_PP); const bf16_t* PROJ = WSP(bf16_t, WS_PROJ);
    bf16_t* Y = WSP(bf16_t, WS_Y);
    const float* g_lru = INP(18); const float* g_mla = INP(19);
    for (int rb = F.vcu; rb < S_ / 32; rb += F.G) {
        const int chunk = rb >> 3;
        __syncthreads();
        { const int c4 = (F.wave * 64 + lane_id()) * 4; f32x4 st = (f32x4){0.f, 0.f, 0.f, 0.f};
          for (int c = 0; c < chunk; c += 8) {
              f32x4 a[8], hh[8];
#pragma unroll
              for (int i = 0; i < 8; ++i) { const int cc = (c + i < chunk) ? c + i : c; a[i] = *(const GAS f32x4*)((const GAS float*)CA + cc * LRUW + c4); hh[i] = *(const GAS f32x4*)((const GAS float*)CH + cc * LRUW + c4); }
#pragma unroll
              for (int i = 0; i < 8; ++i) if (c + i < chunk) st = a[i] * st + hh[i]; }
          *(LAS f32x4*)(carry + c4) = st; }
        __syncthreads();
        for (int rr = 0; rr < 4; rr += 2) {
            const int row0 = rb * 32 + F.wave * 4 + rr, ln = lane_id();
            u32x4 hl[2][4], pp[2][4], gr[2][4], ov[2][4];
#pragma unroll
            for (int q = 0; q < 2; ++q)
#pragma unroll
                for (int j = 0; j < 4; ++j) { const int c0 = 8 * (ln + 64 * j); const size_t row = (size_t)(row0 + q);
                    hl[q][j] = *(const GAS u32x4*)((const GAS bf16_t*)HL + row * LRUW + c0); pp[q][j] = *(const GAS u32x4*)((const GAS bf16_t*)PPi + row * LRUW + c0);
                    gr[q][j] = *(const GAS u32x4*)((const GAS bf16_t*)PROJ + row * NINP + COL_GR + c0); ov[q][j] = *(const GAS u32x4*)((const GAS bf16_t*)Y + row * LDK + LRUW + c0); }
#pragma unroll
            for (int q = 0; q < 2; ++q) {
                const size_t row = (size_t)(row0 + q);
                float y[4][8]; float ss = 0.f, s2 = 0.f;
#pragma unroll
                for (int j = 0; j < 4; ++j) { const int c0 = 8 * (ln + 64 * j);
                    const f32x4 ca = *(const LAS f32x4*)(carry + c0), cb = *(const LAS f32x4*)(carry + c0 + 4);
#pragma unroll
                    for (int e = 0; e < 4; ++e) { const float c_lo = (e < 2) ? ca[2 * e] : cb[2 * e - 4], c_hi = (e < 2) ? ca[2 * e + 1] : cb[2 * e - 3];
                        const float h0 = bflo(hl[q][j][e]) + bflo(pp[q][j][e]) * c_lo, h1 = bfhi(hl[q][j][e]) + bfhi(pp[q][j][e]) * c_hi;
                        const float y0 = h0 * gelu_tanh(bflo(gr[q][j][e])), y1 = h1 * gelu_tanh(bfhi(gr[q][j][e]));
                        y[j][2 * e] = y0; y[j][2 * e + 1] = y1; ss += y0 * y0 + y1 * y1;
                        const float a = bflo(ov[q][j][e]), b = bfhi(ov[q][j][e]); s2 += a * a + b * b; } }
                const float rstd = 1.0f / sqrtf(wave_sum(ss) * (1.0f / LRUW) + EPS), rstd2 = 1.0f / sqrtf(wave_sum(s2) * (1.0f / LRUW) + EPS);
#pragma unroll
                for (int j = 0; j < 4; ++j) { const int c0 = 8 * (ln + 64 * j); const f32x4 g0 = *(const f32x4*)(g_lru + c0), g1 = *(const f32x4*)(g_lru + c0 + 4), m0 = *(const f32x4*)(g_mla + c0), m1 = *(const f32x4*)(g_mla + c0 + 4);
                    u32x4 w; w.x = cvt_pk_bf16(y[j][0] * rstd * g0[0], y[j][1] * rstd * g0[1]); w.y = cvt_pk_bf16(y[j][2] * rstd * g0[2], y[j][3] * rstd * g0[3]);
                    w.z = cvt_pk_bf16(y[j][4] * rstd * g1[0], y[j][5] * rstd * g1[1]); w.w = cvt_pk_bf16(y[j][6] * rstd * g1[2], y[j][7] * rstd * g1[3]);
                    *(GAS u32x4*)((GAS bf16_t*)Y + row * LDK + c0) = w;
                    u32x4 v; v.x = cvt_pk_bf16(bflo(ov[q][j][0]) * rstd2 * m0[0], bfhi(ov[q][j][0]) * rstd2 * m0[1]); v.y = cvt_pk_bf16(bflo(ov[q][j][1]) * rstd2 * m0[2], bfhi(ov[q][j][1]) * rstd2 * m0[3]);
                    v.z = cvt_pk_bf16(bflo(ov[q][j][2]) * rstd2 * m1[0], bfhi(ov[q][j][2]) * rstd2 * m1[1]); v.w = cvt_pk_bf16(bflo(ov[q][j][3]) * rstd2 * m1[2], bfhi(ov[q][j][3]) * rstd2 * m1[3]);
                    *(GAS u32x4*)((GAS bf16_t*)Y + row * LDK + LRUW + c0) = v; }
            }
        }
    }
    __syncthreads();
}

__device__ __forceinline__ void p7_mid(Frame& F) {
    const float* MOD = WSP(float, WS_MOD);
    LAS float* cC = (LAS float*)(F.lds + RING_OFF); LAS float* cD = cC + DM; LAS float* cE = cD + DM;
    for (int ch = (F.wave * 64 + lane_id()); ch < DM; ch += NWAVES * 64) { cC[ch] = MOD[2 * DM + ch] * INP(21)[ch]; cD[ch] = INP(22)[ch] * (1.0f + MOD[4 * DM + ch]); cE[ch] = MOD[3 * DM + ch]; }
    __syncthreads();
    const int gw = F.vcu * NWAVES + F.wave, NGW = F.G * NWAVES;
    const bf16_t* YO = WSP(bf16_t, WS_YO); const float* xin = INP(0);
    for (int row = gw; row < S_; row += NGW) {
        u32x4 yv[8]; float s = 0.f;
#pragma unroll
        for (int j = 0; j < 8; ++j) { yv[j] = *(const u32x4*)(YO + (size_t)row * DM + 8 * (lane_id() + 64 * j));
#pragma unroll
            for (int e = 0; e < 4; ++e) { const float a = bflo(yv[j][e]), b = bfhi(yv[j][e]); s += a * a + b * b; } }
        const float rstd1 = 1.0f / sqrtf(wave_sum(s) * (1.0f / DM) + EPS);
        if (lane_id() == 0) WSP(float, WS_RS1)[row] = rstd1;
        f32x4 x1[8][2]; float s2 = 0.f;
#pragma unroll
        for (int j = 0; j < 8; ++j) { const int c0 = 8 * (lane_id() + 64 * j);
            const f32x4 xa = __builtin_nontemporal_load((const GAS f32x4*)(xin + (size_t)row * DM + c0)), xb = __builtin_nontemporal_load((const GAS f32x4*)(xin + (size_t)row * DM + c0 + 4));
            const f32x4 ca = *(const LAS f32x4*)(cC + c0), cb = *(const LAS f32x4*)(cC + c0 + 4);
            const f32x4 ya = (f32x4){bflo(yv[j][0]), bfhi(yv[j][0]), bflo(yv[j][1]), bfhi(yv[j][1])}, yb = (f32x4){bflo(yv[j][2]), bfhi(yv[j][2]), bflo(yv[j][3]), bfhi(yv[j][3])};
            const f32x4 a = xa + ca * ya * rstd1, b = xb + cb * yb * rstd1;
            x1[j][0] = a; x1[j][1] = b;
            s2 += (a[0] * a[0] + a[1] * a[1]) + (a[2] * a[2] + a[3] * a[3]) + (b[0] * b[0] + b[1] * b[1]) + (b[2] * b[2] + b[3] * b[3]); }
        const float rstd2 = 1.0f / sqrtf(wave_sum(s2) * (1.0f / DM) + EPS);
#pragma unroll
        for (int j = 0; j < 8; ++j) { const int c0 = 8 * (lane_id() + 64 * j);
            const f32x4 da = *(const LAS f32x4*)(cD + c0), db = *(const LAS f32x4*)(cD + c0 + 4), ea = *(const LAS f32x4*)(cE + c0), eb = *(const LAS f32x4*)(cE + c0 + 4);
            const f32x4 ha = x1[j][0] * rstd2 * da + ea, hb = x1[j][1] * rstd2 * db + eb;
            u32x4 w; w.x = cvt_pk_bf16(ha[0], ha[1]); w.y = cvt_pk_bf16(ha[2], ha[3]); w.z = cvt_pk_bf16(hb[0], hb[1]); w.w = cvt_pk_bf16(hb[2], hb[3]);
            *(u32x4*)(WSP(bf16_t, WS_XN) + (size_t)row * LDK + c0) = w; }
    }
    __syncthreads();
}

__device__ __forceinline__ void p10_final(Frame& F) {
    const float* MOD = WSP(float, WS_MOD);
    LAS float* cF = (LAS float*)(F.lds + RING_OFF); LAS float* cC = cF + DM;
    for (int ch = (F.wave * 64 + lane_id()); ch < DM; ch += NWAVES * 64) { cF[ch] = MOD[5 * DM + ch] * INP(26)[ch]; cC[ch] = MOD[2 * DM + ch] * INP(21)[ch]; }
    __syncthreads();
    const int gw = F.vcu * NWAVES + F.wave, NGW = F.G * NWAVES;
    const GAS bf16_t* FB = (const GAS bf16_t*)WSP(bf16_t, WS_F); const GAS bf16_t* YO = (const GAS bf16_t*)WSP(bf16_t, WS_YO); const GAS float* X = (const GAS float*)INP(0);
    for (int row = gw; row < S_; row += NGW) {
        u32x4 fv[8]; float s = 0.f;
#pragma unroll
        for (int j = 0; j < 8; ++j) { fv[j] = *(const GAS u32x4*)(FB + (size_t)row * DM + 8 * (lane_id() + 64 * j));
#pragma unroll
            for (int e = 0; e < 4; ++e) { const float a = bflo(fv[j][e]), b = bfhi(fv[j][e]); s += a * a + b * b; } }
        const float rstd = 1.0f / sqrtf(wave_sum(s) * (1.0f / DM) + EPS);
        const float rstd1 = WSP(float, WS_RS1)[row];
#pragma unroll
        for (int j = 0; j < 8; ++j) { const int c0 = 8 * (lane_id() + 64 * j);
            const f32x4 xa = __builtin_nontemporal_load((const GAS f32x4*)(X + (size_t)row * DM + c0)), xb = __builtin_nontemporal_load((const GAS f32x4*)(X + (size_t)row * DM + c0 + 4));
            const f32x4 ca = *(const LAS f32x4*)(cF + c0), cb = *(const LAS f32x4*)(cF + c0 + 4), da = *(const LAS f32x4*)(cC + c0), db = *(const LAS f32x4*)(cC + c0 + 4);
            const f32x4 fa = (f32x4){bflo(fv[j][0]), bfhi(fv[j][0]), bflo(fv[j][1]), bfhi(fv[j][1])}, fb = (f32x4){bflo(fv[j][2]), bfhi(fv[j][2]), bflo(fv[j][3]), bfhi(fv[j][3])};
            const u32x4 yw = *(const GAS u32x4*)(YO + (size_t)row * DM + c0);
            const f32x4 ya = (f32x4){bflo(yw[0]), bfhi(yw[0]), bflo(yw[1]), bfhi(yw[1])}, yb = (f32x4){bflo(yw[2]), bfhi(yw[2]), bflo(yw[3]), bfhi(yw[3])};
            const f32x4 x1a = xa + da * ya * rstd1, x1b = xb + db * yb * rstd1;
            GAS float* op = (GAS float*)F.out + (size_t)row * DM + c0;
            __builtin_nontemporal_store(x1a + ca * fa * rstd, (GAS f32x4*)op); __builtin_nontemporal_store(x1b + cb * fb * rstd, (GAS f32x4*)(op + 4));
            if ((j & 3) == 3) __builtin_amdgcn_sched_barrier(0); }
    }
}

constexpr int NPH = 12;
struct Args { const float* in[27]; float* out; unsigned char* ws; int ph_lo, ph_hi, li, pad; };

template <class Epi, bool ALIGN>
__device__ __forceinline__ void run_gemm(Frame& F, const pg8::Gemm& g, const Epi& E) {
    pg8::StaticOrder S; S.init(g.M, g.N, F.G, (int)blockIdx.x);
    pg8::gemm_phase<Epi, pg8::StaticOrder, ALIGN>(F.lds + RING_OFF, g, S, E);
}

__global__ void __launch_bounds__(NWAVES * 64, 2) mk_fwd(Args args) {
    extern __shared__ __attribute__((aligned(16))) unsigned char lds_raw[];
    Frame F;
    F.lds = (LAS unsigned char*)lds_raw;
    F.wave = __builtin_amdgcn_readfirstlane((int)threadIdx.x >> 6);
    F.G = gridDim.x; { const int bx = blockIdx.x; F.vcu = (F.G % 8 == 0) ? (bx % 8) * (F.G / 8) + bx / 8 : bx; }
    F.out = args.out; F.ws = args.ws;
    unsigned* bar_region = (unsigned*)(F.ws + WS_CTL) + CW_BAR + args.li * 4096;
    XcdBarrier bar = xcd_barrier_post(bar_region, bar_region + XCD_BAR_WORDS + 2 * blockIdx.x);
#define GRID_BAR() xcd_barrier(bar)
    const int lo = args.ph_lo, hi = args.ph_hi;
#define IN(k) (lo <= (k) && (k) < hi)
#define BOTH(k) (IN(k) && IN((k) + 1))

    if (IN(0)) { p0a_prep(F); if (BOTH(0)) GRID_BAR(); }
    if (IN(1)) { p0b_xn(F); if (BOTH(1)) GRID_BAR(); }
    if (IN(2)) {
        pg8::Gemm g{WSP(bf16_t, WS_XN), WSP(bf16_t, WS_WIN), S_, NINP, DM, LDK, LDK};
        pg8::EpiStore E{WSP(bf16_t, WS_PROJ), NINP};
        run_gemm<pg8::EpiStore, true>(F, g, E);
        const int first = ((S_ / 256) * (NINP / 256)) % F.G;
        if ((int)blockIdx.x >= first) { LAS float* scr = (LAS float*)(F.lds + RING_OFF + F.wave * 16384); const int lw = ((int)blockIdx.x - first) * NWAVES + F.wave, nlw = (F.G - first) * NWAVES;
            const float* wsrc = INP(20); TR_RUN(tr_plain(wsrc, DM, WSP(bf16_t, WS_WOUT), LDK, r), lw, nlw, 128 * (DM / 64), scr); }
        if (BOTH(2)) GRID_BAR();
    }
    if (IN(3)) { p2_thin(F); if (BOTH(3)) GRID_BAR(); }
    if (IN(4)) {
        { pg8::Gemm g{WSP(bf16_t, WS_PROJ) + COL_QL, WSP(bf16_t, WS_WQ), S_, NH * 192, QL, NINP, QL};
          pg8::EpiQ E{WSP(bf16_t, WS_QN), WSP(bf16_t, WS_QPE), WSP(float, WS_RSQ), WSP(f32x2, WS_CS)};
          run_gemm<pg8::EpiQ, true>(F, g, E);
          const int first = ((S_ / 256) * (NH * 192 / 256)) % F.G;
          if (first > 0 && (int)blockIdx.x >= first) { LAS float* scr = (LAS float*)(F.lds + RING_OFF + F.wave * 16384); const int lw = ((int)blockIdx.x - first) * NWAVES + F.wave, nlw = (F.G - first) * NWAVES;
              const float* wg = INP(23); const float* wu = INP(24); TR_RUN(wgu_item(wg, wu, WSP(bf16_t, WS_WGU), r, WGU_KB_P0A), lw, nlw, 688 * (64 - WGU_KB_P0A), scr); }
          else if (first == 0) { LAS float* scr = (LAS float*)(F.lds + RING_OFF + F.wave * 16384); const float* wg = INP(23); const float* wu = INP(24);
              TR_RUN(wgu_item(wg, wu, WSP(bf16_t, WS_WGU), r, WGU_KB_P0A), F.vcu * NWAVES + F.wave, F.G * NWAVES, 688 * (64 - WGU_KB_P0A), scr); }
          __syncthreads(); }
        { pg8::Gemm g{WSP(bf16_t, WS_PROJ) + COL_KVL, WSP(bf16_t, WS_WKV), S_, NH * 256, KVL, NINP, KVL};
          pg8::EpiKV E{WSP(bf16_t, WS_KT), WSP(bf16_t, WS_VT), WSP(float, WS_RSKV)};
          run_gemm<pg8::EpiKV, true>(F, g, E); }
        { const int gw = F.vcu * NWAVES + F.wave, NGW = F.G * NWAVES;
          for (int task = gw; task < 32 * 16 * 4; task += NGW) lru_task(F, task); }
        if (BOTH(4)) GRID_BAR();
    }
    if (IN(5)) { attn_phase(F); if (BOTH(5)) GRID_BAR(); }
    if (IN(6)) { p5_finalize(F); if (BOTH(6)) GRID_BAR(); }
    if (IN(7)) {
        pg8::Gemm g{WSP(bf16_t, WS_Y), WSP(bf16_t, WS_WOUT), S_, DM, DM, LDK, LDK};
        pg8::EpiStore E{WSP(bf16_t, WS_YO), DM};
        run_gemm<pg8::EpiStore, true>(F, g, E);
        if (BOTH(7)) GRID_BAR();
    }
    if (IN(8)) { p7_mid(F); if (BOTH(8)) GRID_BAR(); }
    if (IN(9)) {
        pg8::Gemm g{WSP(bf16_t, WS_XN), WSP(bf16_t, WS_WGU), S_, NGU, DM, LDK, LDK};
        pg8::EpiGU E{WSP(bf16_t, WS_H)};
        run_gemm<pg8::EpiGU, true>(F, g, E);
        const int first = ((S_ / 256) * (NGU / 256)) % F.G;
        if ((int)blockIdx.x >= first) { LAS float* scr = (LAS float*)(F.lds + RING_OFF + F.wave * 16384); const int lw = ((int)blockIdx.x - first) * NWAVES + F.wave, nlw = (F.G - first) * NWAVES;
            const float* wsrc = INP(25); TR_RUN(tr_plain(wsrc, DM, WSP(bf16_t, WS_WDN), DFF, r), lw, nlw, 128 * (DFF / 64), scr); }
        if (BOTH(9)) GRID_BAR();
    }
    if (IN(10)) {
        pg8::Gemm g{WSP(bf16_t, WS_H), WSP(bf16_t, WS_WDN), S_, DM, DFF, DFF, DFF};
        pg8::EpiStore E{WSP(bf16_t, WS_F), DM};
        run_gemm<pg8::EpiStore, true>(F, g, E);
        if (BOTH(10)) GRID_BAR();
    }
    if (IN(11)) { p10_final(F); }
#undef IN
#undef BOTH
}

extern "C" void kernel_launch(void* const* d_in, const int* in_sizes, int n_in, void* d_out, int out_size, void* d_ws, size_t ws_size, hipStream_t stream) {
    static int grid = 0;
    if (grid == 0) {
        if (n_in != 27 || in_sizes[0] != S_ * DM || out_size != S_ * DM || ws_size < WS_END) {
            fprintf(stderr, "kernel_launch: unexpected shapes: n_in %d in0 %d out %d ws %zu (need >= %zu)\n", n_in, n_in > 0 ? in_sizes[0] : -1, out_size, ws_size, (size_t)WS_END); grid = -1; return; }
        int dev = 0, cus = 0, per_cu = 0;
        if (hipGetDevice(&dev) != hipSuccess || hipDeviceGetAttribute(&cus, hipDeviceAttributeMultiprocessorCount, dev) != hipSuccess) { grid = -1; return; }
        if (hipFuncSetAttribute((const void*)mk_fwd, hipFuncAttributeMaxDynamicSharedMemorySize, LDS_BYTES) != hipSuccess) { fprintf(stderr, "kernel_launch: hipFuncSetAttribute failed\n"); grid = -1; return; }
        if (hipOccupancyMaxActiveBlocksPerMultiprocessor(&per_cu, (const void*)mk_fwd, NWAVES * 64, LDS_BYTES) != hipSuccess || per_cu < 1)
            fprintf(stderr, "kernel_launch: note: occupancy query reports %d workgroups per CU\n", per_cu);
        (void)hipGetLastError();
        grid = cus;
    }
    if (grid < 0) return;
    (void)hipMemsetAsync((char*)d_ws + WS_CTL, 0, CTL_ZERO_BYTES, stream);
    (void)hipMemsetAsync((char*)d_ws + WS_WIN + (size_t)NIN * LDK * 2, 0, (size_t)(NINP - NIN) * LDK * 2, stream);
    Args a{};
    for (int i = 0; i < 27; ++i) a.in[i] = (const float*)d_in[i];
    a.out = (float*)d_out; a.ws = (unsigned char*)d_ws;
    static const int launch_list[][2] = { LAUNCH_LIST };
    constexpr int n_launch = (int)(sizeof(launch_list) / sizeof(launch_list[0]));
    static_assert(n_launch <= 32 && (CW_BAR + 32 * 4096) * 4 <= (int)CTL_ZERO_BYTES, "barrier regions");
    for (int li = 0; li < n_launch; ++li) {
        a.ph_lo = launch_list[li][0]; a.ph_hi = launch_list[li][1]; a.li = li; a.pad = 0;
        hipLaunchKernelGGL(mk_fwd, dim3(grid), dim3(NWAVES * 64), LDS_BYTES, stream, a);
        const hipError_t le = hipPeekAtLastError();
        if (le != hipSuccess) { fprintf(stderr, "kernel_launch: launch %d failed: %s\n", li, hipGetErrorName(le)); break; }
    }
}
```

```cpp
#include <hip/hip_runtime.h>
#include <cstdio>
#include <cstdint>

#ifndef LAUNCH_LIST
#define LAUNCH_LIST {0, 12}
#endif

#define LAS __attribute__((address_space(3)))
#define GAS __attribute__((address_space(1)))
typedef unsigned short bf16_t;
typedef short bf16x8 __attribute__((ext_vector_type(8)));
typedef float f32x4 __attribute__((ext_vector_type(4)));
typedef float f32x2 __attribute__((ext_vector_type(2)));
typedef float f32x16 __attribute__((ext_vector_type(16)));
typedef unsigned u32x4 __attribute__((ext_vector_type(4)));
typedef unsigned u32x2 __attribute__((ext_vector_type(2)));
typedef short s16x4 __attribute__((ext_vector_type(4)));

constexpr int S_ = 8192, DM = 4096, NIN = 5696, NINP = 5888, LRUW = 2048, QL = 1024, KVL = 512, ROPE = 64;
constexpr int NH = 16, NOPE = 128, VD = 128, DFF = 11008, NGU = 2 * DFF, NMOD = 6 * DM;
constexpr int COL_GR = 2048, COL_QL = 4096, COL_KVL = 5120, COL_KR = 5632;
constexpr float EPS = 1e-6f;
constexpr float QSCALE = 0.07216878364870322f * 1.4426950408889634f;

__device__ __forceinline__ unsigned cvt_pk_bf16(float lo, float hi) { unsigned r; asm volatile("v_cvt_pk_bf16_f32 %0, %1, %2" : "=v"(r) : "v"(lo), "v"(hi)); return r; }
__device__ __forceinline__ float bflo(unsigned w) { return __uint_as_float(w << 16); }
__device__ __forceinline__ float bfhi(unsigned w) { return __uint_as_float(w & 0xffff0000u); }
__device__ __forceinline__ float bf1(bf16_t b) { return __uint_as_float((unsigned)b << 16); }
__device__ __forceinline__ float wave_sum(float v) {
#pragma unroll
    for (int o = 1; o < 64; o <<= 1) v += __shfl_xor(v, o);
    return v;
}
__device__ __forceinline__ float sigmoidf_(float z) { return 1.0f / (1.0f + __expf(-z)); }
__device__ __forceinline__ float gelu_tanh(float x) { const float z = 0.7978845608028654f * (x + 0.044715f * x * x * x); const float t = 1.0f - 2.0f / (1.0f + __expf(2.0f * z)); return 0.5f * x * (1.0f + t); }

__device__ __forceinline__ void glds16(const void* sbase, unsigned voff, unsigned lds_dst) {
    unsigned keep;
    asm volatile("s_mov_b32 %0, m0\n\ts_mov_b32 m0, %3\n\ts_nop 0\n\tglobal_load_lds_dwordx4 %1, %2\n\ts_mov_b32 m0, %0" : "=&s"(keep) : "v"(voff), "s"(sbase), "s"(lds_dst) : "memory");
}
namespace pg8 {
constexpr int BM = 256, BK = 64, HALF = 128, HTB = HALF * BK * 2, STAGE_BYTES = 8 * HTB, NXCD = 8, WGM = 8;
__host__ __device__ __forceinline__ int lds_byte(int r, int c) { const int st = (r >> 4) * 2 + (c >> 5), rr = r & 15, cc = c & 31, ob = rr * 64 + cc * 2; return st * 1024 + (ob ^ (((ob >> 9) & 1) << 5)); }
__host__ __device__ __forceinline__ void stage_rc(int b, int& R, int& C) { const int st = b / 1024, sb = b % 1024, swz = sb ^ (((sb >> 9) & 1) << 5); R = (st >> 1) * 16 + swz / 64; C = (st & 1) * 32 + (swz % 64) / 2; }
__host__ __device__ __forceinline__ int perm32(int rho) { const int n = rho >> 4, i = rho & 15; return 8 * (i >> 2) + 4 * n + (i & 3); }
struct Unit { int pm, pn; };
struct Gemm { const bf16_t* A; const bf16_t* Bt; int M, N, K, lda, ldb; };
struct StaticOrder {
    int nM, nN, nwg, G, c;
    __host__ __device__ void init(int M, int N, int G_, int c_) { nM = M / BM; nN = N / BM; nwg = nM * nN; G = G_; c = c_; }
    __host__ __device__ bool next(int i, Unit& u) const {
        const long L = (long)i * G + c; if (L >= nwg) return false;
        int wgid = (int)L; { const int q = nwg / NXCD, r = nwg % NXCD, xcd = wgid % NXCD, off = wgid / NXCD; wgid = (xcd < r ? xcd * (q + 1) : r * (q + 1) + (xcd - r) * q) + off; }
        const int nig = WGM * nN, gid = wgid / nig, fm = gid * WGM, gsz = (nM - fm) < WGM ? (nM - fm) : WGM;
        u.pm = fm + ((wgid % nig) % gsz); u.pn = (wgid % nig) / gsz; return true;
    }
    __device__ __forceinline__ void a_ready(const Unit&) const {}
    __device__ __forceinline__ void done(const Unit&) const {}
};

template <class Epi, class Sched, bool ALIGN_EPI>
__device__ __forceinline__ void gemm_phase(LAS unsigned char* lds, const Gemm g, const Sched& S, const Epi& E) {
    const int tid = threadIdx.x, wid = __builtin_amdgcn_readfirstlane(tid >> 6), lane = tid & 63, wr = wid >> 2, wc = wid & 3, fr = lane & 15, fq = lane >> 4;
    const int K = g.K, nt = K / BK;
    unsigned voffA[2], voffB[2];
#pragma unroll
    for (int i = 0; i < 2; ++i) { int R, C; stage_rc(tid * 16 + i * 8192, R, C); const int Rb = (R & ~31) + perm32(R & 31);
        voffA[i] = (unsigned)(R * g.lda + C) * 2u; voffB[i] = (unsigned)(Rb * g.ldb + C) * 2u; }
    const size_t kstep = (size_t)(BK * 2);
    const size_t hstepA = (size_t)HALF * g.lda * 2, hstepB = (size_t)HALF * g.ldb * 2;
    const size_t tstepA = 2 * hstepA, tstepB = 2 * hstepB;
    const unsigned ldsw = (unsigned)wid * 1024u;
    const int aoff = lds_byte(wr * 64 + fr, fq * 8), boff = lds_byte(wc * 32 + fr, fq * 8);
#define PG8_SA(b, h) (((b) * 2 + (h)) * HTB)
#define PG8_SB(b, h) ((4 + (b) * 2 + (h)) * HTB)
#define PG8_STAGE(bufoff, gbase, voff) do { _Pragma("unroll") for (int _i = 0; _i < 2; ++_i) \
        __builtin_amdgcn_global_load_lds((const unsigned*)((const char*)(gbase) + (voff)[_i]), (LAS unsigned*)(lds + (bufoff) + ldsw + _i * 8192), 16, 0, 0); } while (0)
#define PG8_LDA(dst, b, h) do { _Pragma("unroll") for (int m = 0; m < 4; ++m) _Pragma("unroll") for (int k = 0; k < 2; ++k) dst[m][k] = *(const LAS bf16x8*)(lds + PG8_SA(b, h) + aoff + m * 2048 + k * 1024); } while (0)
#define PG8_LDB(dst, b, h) do { _Pragma("unroll") for (int n = 0; n < 2; ++n) _Pragma("unroll") for (int k = 0; k < 2; ++k) dst[n][k] = *(const LAS bf16x8*)(lds + PG8_SB(b, h) + boff + n * 2048 + k * 1024); } while (0)
#define PG8_MMA(ai, bj, At, Bt) do { __builtin_amdgcn_s_setprio(1); _Pragma("unroll") for (int m = 0; m < 4; ++m) _Pragma("unroll") for (int n = 0; n < 2; ++n) _Pragma("unroll") for (int k = 0; k < 2; ++k) \
        acc[ai][bj][m][n] = __builtin_amdgcn_mfma_f32_16x16x32_bf16(Bt[n][k], At[m][k], acc[ai][bj][m][n], 0, 0, 0); __builtin_amdgcn_s_setprio(0); } while (0)
#define PG8_WAIT_V(n) asm volatile("s_waitcnt vmcnt(" #n ")" ::: "memory")
#define PG8_WAIT_L(n) asm volatile("s_waitcnt lgkmcnt(" #n ")" ::: "memory")
#define PG8_BAR __builtin_amdgcn_s_barrier()
#define PG8_SCHED __builtin_amdgcn_sched_barrier(0)
    Unit cur, nxt; int ui = 0;
    if (!S.next(0, cur)) return;
    f32x4 acc[2][2][4][2];
#pragma unroll
    for (int a = 0; a < 2; ++a)
#pragma unroll
        for (int b = 0; b < 2; ++b)
#pragma unroll
            for (int m = 0; m < 4; ++m)
#pragma unroll
                for (int n = 0; n < 2; ++n) acc[a][b][m][n] = (f32x4){0.f, 0.f, 0.f, 0.f};
    bf16x8 At[4][2], B0[2][2], B1[2][2];
    const char* cA = (const char*)g.A + (size_t)cur.pm * tstepA; const char* cB = (const char*)g.Bt + (size_t)cur.pn * tstepB;
    S.a_ready(cur);
    PG8_STAGE(PG8_SB(0, 0), cB, voffB); PG8_STAGE(PG8_SB(0, 1), cB + hstepB, voffB); PG8_STAGE(PG8_SA(0, 0), cA, voffA); PG8_STAGE(PG8_SA(0, 1), cA + hstepA, voffA);
    if (wr == 1) PG8_BAR;
    PG8_WAIT_V(2); PG8_BAR;
    PG8_STAGE(PG8_SB(1, 0), cB + kstep, voffB); PG8_STAGE(PG8_SA(1, 0), cA + kstep, voffA); PG8_STAGE(PG8_SB(1, 1), cB + hstepB + kstep, voffB);
    PG8_WAIT_V(6); PG8_BAR;
    for (;;) {
        const bool has_next = S.next(ui + 1, nxt);
        const char* nA = has_next ? (const char*)g.A + (size_t)nxt.pm * tstepA : cA; const char* nB = has_next ? (const char*)g.Bt + (size_t)nxt.pn * tstepB : cB;
        for (int t = 0; t < nt; t += 2) {
            const bool last = (t == nt - 2);
            const char* a1 = cA + (size_t)(t + 1) * kstep;
            const char* a2 = last ? nA : cA + (size_t)(t + 2) * kstep; const char* b2 = last ? nB : cB + (size_t)(t + 2) * kstep;
            const char* a3 = a2 + kstep; const char* b3 = b2 + kstep;
            if (last && has_next) S.a_ready(nxt);
            PG8_LDB(B0, 0, 0); PG8_LDB(B1, 0, 1); PG8_SCHED; PG8_LDA(At, 0, 0); PG8_STAGE(PG8_SA(1, 1), a1 + hstepA, voffA);
            PG8_WAIT_V(8); PG8_WAIT_L(0); PG8_BAR; PG8_MMA(0, 0, At, B0); PG8_MMA(0, 1, At, B1); PG8_BAR; PG8_SCHED;
            PG8_LDA(At, 0, 1); PG8_STAGE(PG8_SB(0, 0), b2, voffB); PG8_STAGE(PG8_SB(0, 1), b2 + hstepB, voffB); PG8_STAGE(PG8_SA(0, 0), a2, voffA);
            PG8_WAIT_V(8); PG8_WAIT_L(0); PG8_BAR; PG8_MMA(1, 0, At, B0); PG8_MMA(1, 1, At, B1); PG8_BAR; PG8_SCHED;
            PG8_LDB(B0, 1, 0); PG8_LDB(B1, 1, 1); PG8_SCHED; PG8_LDA(At, 1, 0); PG8_STAGE(PG8_SA(0, 1), a2 + hstepA, voffA);
            PG8_WAIT_V(8); PG8_WAIT_L(0); PG8_BAR; PG8_MMA(0, 0, At, B0); PG8_MMA(0, 1, At, B1); PG8_BAR; PG8_SCHED;
            PG8_LDA(At, 1, 1); PG8_STAGE(PG8_SB(1, 0), b3, voffB); PG8_STAGE(PG8_SB(1, 1), b3 + hstepB, voffB); PG8_STAGE(PG8_SA(1, 0), a3, voffA);
            PG8_WAIT_V(8); PG8_WAIT_L(0); PG8_BAR; PG8_MMA(1, 0, At, B0); PG8_MMA(1, 1, At, B1); PG8_BAR; PG8_SCHED;
        }
        if constexpr (ALIGN_EPI) { if (wr == 0) PG8_BAR; }
        E(acc, cur, wr, wc, fr, fq); S.done(cur);
        if (!has_next) break;
#pragma unroll
        for (int a = 0; a < 2; ++a)
#pragma unroll
            for (int b = 0; b < 2; ++b)
#pragma unroll
                for (int m = 0; m < 4; ++m)
#pragma unroll
                    for (int n = 0; n < 2; ++n) acc[a][b][m][n] = (f32x4){0.f, 0.f, 0.f, 0.f};
        cur = nxt; cA = nA; cB = nB; ++ui;
        if constexpr (ALIGN_EPI) { if (wr == 1) PG8_BAR; }
    }
    PG8_WAIT_V(0);
    if constexpr (!ALIGN_EPI) { if (wr == 0) PG8_BAR; }
    PG8_BAR;
#undef PG8_SA
#undef PG8_SB
#undef PG8_STAGE
#undef PG8_LDA
#undef PG8_LDB
#undef PG8_MMA
#undef PG8_WAIT_V
#undef PG8_WAIT_L
#undef PG8_BAR
#undef PG8_SCHED
}

struct EpiStore {
    bf16_t* O; int ldc;
    __device__ __forceinline__ void operator()(const f32x4 (&acc)[2][2][4][2], const Unit& u, int wr, int wc, int fr, int fq) const {
        const int row0 = u.pm * BM + wr * 64 + fr, col0 = u.pn * BM + wc * 32 + 8 * fq;
#pragma unroll
        for (int ai = 0; ai < 2; ++ai)
#pragma unroll
            for (int m = 0; m < 4; ++m) { bf16_t* rowp = O + (size_t)(row0 + ai * HALF + m * 16) * ldc + col0;
#pragma unroll
                for (int bj = 0; bj < 2; ++bj) { const f32x4 v0 = acc[ai][bj][m][0], v1 = acc[ai][bj][m][1];
                    u32x4 w; w.x = cvt_pk_bf16(v0[0], v0[1]); w.y = cvt_pk_bf16(v0[2], v0[3]); w.z = cvt_pk_bf16(v1[0], v1[1]); w.w = cvt_pk_bf16(v1[2], v1[3]);
                    *(u32x4*)(rowp + bj * HALF) = w; } }
    }
};
struct EpiKV {
    bf16_t* KT; bf16_t* VT; const float* rs;
    __device__ __forceinline__ void operator()(const f32x4 (&acc)[2][2][4][2], const Unit& u, int wr, int wc, int fr, int fq) const {
        const int row0 = u.pm * BM + wr * 64 + fr;
#pragma unroll
        for (int ai = 0; ai < 2; ++ai)
#pragma unroll
            for (int m = 0; m < 4; ++m) { const int row = row0 + ai * HALF + m * 16; const float s = rs[row];
                const int tile = row >> 6, k = row & 63; const size_t tb = ((size_t)u.pn * 128 + tile) * 8192;
                { const f32x4 v0 = acc[ai][0][m][0] * s, v1 = acc[ai][0][m][1] * s;
                  u32x4 w; w.x = cvt_pk_bf16(v0[0], v0[1]); w.y = cvt_pk_bf16(v0[2], v0[3]); w.z = cvt_pk_bf16(v1[0], v1[1]); w.w = cvt_pk_bf16(v1[2], v1[3]);
                  *(u32x4*)(KT + tb + (4 * wc + fq) * 512 + k * 8) = w; }
                { const f32x4 v0 = acc[ai][1][m][0] * s, v1 = acc[ai][1][m][1] * s;
                  u32x4 w; w.x = cvt_pk_bf16(v0[0], v0[1]); w.y = cvt_pk_bf16(v0[2], v0[3]); w.z = cvt_pk_bf16(v1[0], v1[1]); w.w = cvt_pk_bf16(v1[2], v1[3]);
                  const int kk = (k & ~0xC) | ((k & 4) << 1) | ((k & 8) >> 1), c0 = 32 * wc + 8 * fq;
                  *(u32x4*)(VT + tb + ((kk >> 3) * 4 + (c0 >> 5)) * 256 + (kk & 7) * 32 + (c0 & 31)) = w; } }
    }
};
struct EpiQ {
    bf16_t* QN; bf16_t* QPE; const float* rs; const f32x2* cs;
    __device__ __forceinline__ void operator()(const f32x4 (&acc)[2][2][4][2], const Unit& u, int wr, int wc, int fr, int fq) const {
        const int row0 = u.pm * BM + wr * 64 + fr;
        if (u.pn < 8) {
            const int col0 = u.pn * BM + wc * 32 + 8 * fq;
#pragma unroll
            for (int ai = 0; ai < 2; ++ai)
#pragma unroll
                for (int m = 0; m < 4; ++m) { const int row = row0 + ai * HALF + m * 16; const float s = rs[row] * QSCALE; bf16_t* rowp = QN + (size_t)row * 2048 + col0;
#pragma unroll
                    for (int bj = 0; bj < 2; ++bj) { const f32x4 v0 = acc[ai][bj][m][0] * s, v1 = acc[ai][bj][m][1] * s;
                        u32x4 w; w.x = cvt_pk_bf16(v0[0], v0[1]); w.y = cvt_pk_bf16(v0[2], v0[3]); w.z = cvt_pk_bf16(v1[0], v1[1]); w.w = cvt_pk_bf16(v1[2], v1[3]);
                        *(u32x4*)(rowp + bj * HALF) = w; } }
        } else {
            const int head = 4 * (u.pn - 8) + wc, j0 = 8 * fq;
#pragma unroll
            for (int ai = 0; ai < 2; ++ai)
#pragma unroll
                for (int m = 0; m < 4; ++m) { const int row = row0 + ai * HALF + m * 16; const float s = rs[row] * QSCALE;
                    const f32x4* cp = (const f32x4*)(cs + (size_t)row * 32 + j0);
                    float o1[8], o2[8];
#pragma unroll
                    for (int q = 0; q < 4; ++q) { const f32x4 c2 = cp[q];
                        const int n = q >> 1, e = (q & 1) * 2;
                        const float x1a = acc[ai][0][m][n][e] * s, x2a = acc[ai][1][m][n][e] * s, x1b = acc[ai][0][m][n][e + 1] * s, x2b = acc[ai][1][m][n][e + 1] * s;
                        o1[2 * q] = x1a * c2[0] - x2a * c2[1]; o2[2 * q] = x2a * c2[0] + x1a * c2[1];
                        o1[2 * q + 1] = x1b * c2[2] - x2b * c2[3]; o2[2 * q + 1] = x2b * c2[2] + x1b * c2[3]; }
                    bf16_t* rowp = QPE + (size_t)row * 1024 + head * 64 + j0;
                    u32x4 w1, w2; w1.x = cvt_pk_bf16(o1[0], o1[1]); w1.y = cvt_pk_bf16(o1[2], o1[3]); w1.z = cvt_pk_bf16(o1[4], o1[5]); w1.w = cvt_pk_bf16(o1[6], o1[7]);
                    w2.x = cvt_pk_bf16(o2[0], o2[1]); w2.y = cvt_pk_bf16(o2[2], o2[3]); w2.z = cvt_pk_bf16(o2[4], o2[5]); w2.w = cvt_pk_bf16(o2[6], o2[7]);
                    *(u32x4*)rowp = w1; *(u32x4*)(rowp + 32) = w2; }
        }
    }
};
struct EpiGU {
    bf16_t* H;
    __device__ __forceinline__ void operator()(const f32x4 (&acc)[2][2][4][2], const Unit& u, int wr, int wc, int fr, int fq) const {
        const int row0 = u.pm * BM + wr * 64 + fr, col0 = u.pn * HALF + wc * 32 + 8 * fq;
#pragma unroll
        for (int ai = 0; ai < 2; ++ai)
#pragma unroll
            for (int m = 0; m < 4; ++m) { bf16_t* rowp = H + (size_t)(row0 + ai * HALF + m * 16) * DFF + col0;
                float h[8];
#pragma unroll
                for (int n = 0; n < 2; ++n)
#pragma unroll
                    for (int e = 0; e < 4; ++e) { const float gv = acc[ai][0][m][n][e], uv = acc[ai][1][m][n][e]; h[4 * n + e] = gv * __builtin_amdgcn_rcpf(1.0f + __expf(-gv)) * uv; }
                u32x4 w; w.x = cvt_pk_bf16(h[0], h[1]); w.y = cvt_pk_bf16(h[2], h[3]); w.z = cvt_pk_bf16(h[4], h[5]); w.w = cvt_pk_bf16(h[6], h[7]);
                *(u32x4*)rowp = w; }
    }
};
}

constexpr size_t MiB = 1u << 20;
constexpr size_t WS_CTL = 0, CTL_ZERO_BYTES = 1 * MiB;
constexpr size_t WS_MODP = 1 * MiB;
constexpr size_t WS_MOD = 3 * MiB;
constexpr size_t WS_CS = 4 * MiB;
constexpr size_t WS_RSQ = 6 * MiB;
constexpr size_t WS_RSKV = 6 * MiB + 65536;
constexpr size_t WS_RS1 = 6 * MiB + 131072;
constexpr size_t WS_CA = 7 * MiB;
constexpr size_t WS_CH = 7 * MiB + 512 * 1024;
constexpr size_t WS_WIN = 8 * MiB;
constexpr size_t WS_WQ = 54 * MiB;
constexpr size_t WS_WKV = 60 * MiB;
constexpr size_t WS_WG = 64 * MiB;
constexpr size_t WS_WOUT = 66 * MiB;
constexpr size_t WS_WGU = 98 * MiB;
constexpr size_t WS_WDN = 270 * MiB;
constexpr size_t WS_XN = 356 * MiB;
constexpr size_t WS_PROJ = 420 * MiB;
constexpr size_t WS_XC = 512 * MiB;
constexpr size_t WS_QN = 544 * MiB;
constexpr size_t WS_QPE = 576 * MiB;
constexpr size_t WS_KT = 592 * MiB;
constexpr size_t WS_VT = 624 * MiB;
constexpr size_t WS_KPE = 656 * MiB;
constexpr size_t WS_HLOC = 658 * MiB;
constexpr size_t WS_PP = 690 * MiB;
constexpr size_t WS_Y = 722 * MiB;
constexpr size_t WS_YO = 786 * MiB;
constexpr size_t WS_H = 850 * MiB;
constexpr size_t WS_F = 1022 * MiB;
constexpr size_t WS_END = 1086 * MiB;
constexpr int CW_BAR = 4096;

constexpr int RING_OFF = 0, RING_BYTES = 131072;
constexpr int FILL_OFF = 131072;
constexpr int LDS_BYTES = 163840;
constexpr int LDSCTL_OFF = 135168;
constexpr int NWAVES = 8;

#define LDS_WAIT() asm volatile("s_waitcnt lgkmcnt(0)" ::: "memory")
#define VM_WAIT() asm volatile("s_waitcnt vmcnt(0)" ::: "memory")

#define XB_TMO      128
#define XB_XCNT(j)  (256  + 64 * (j))
#define XB_XSUB(j)  (1280 + 64 * (j))
#define XB_XGEN(j)  (2304 + 64 * (j))
#define XB_TOP      3328
#define XB_TOPGEN   3392
#define XCD_BAR_WORDS 3456
#define XB_SPIN_CAP (1u << 18)
__device__ __forceinline__ unsigned xb_ld(unsigned* p)              { return __hip_atomic_load(p, __ATOMIC_RELAXED, __HIP_MEMORY_SCOPE_AGENT); }
__device__ __forceinline__ unsigned xb_add(unsigned* p, unsigned v) { return __hip_atomic_fetch_add(p, v, __ATOMIC_RELAXED, __HIP_MEMORY_SCOPE_AGENT); }
__device__ __forceinline__ unsigned xb_xcc_id() { return (unsigned)__builtin_amdgcn_s_getreg((3 << 11) | 20) & 0xFu; }
#define XB_SPIN(cond, bar) do { unsigned _sp = 0; while (cond) { __builtin_amdgcn_s_sleep(1); \
    if ((++_sp & 255u) == 0u) { if (xb_ld(&(bar)[XB_TMO])) break; if (_sp > XB_SPIN_CAP) { atomicAdd(&(bar)[XB_TMO], 1u); break; } } } } while (0)
struct XcdBarrier { unsigned* bar; unsigned x; unsigned* st; };
__device__ __forceinline__ XcdBarrier xcd_barrier_post(unsigned* bar, unsigned* st) {
    XcdBarrier b; b.bar = bar; b.x = xb_xcc_id(); b.st = st;
    if (threadIdx.x == 0) (void)xb_add(&bar[XB_XCNT(b.x)], 1u);
    return b;
}
__device__ __forceinline__ void xcd_barrier_complete(unsigned* bar, unsigned x, unsigned& nloc, unsigned& nx) {
    const unsigned G = gridDim.x * gridDim.y * gridDim.z;
    unsigned sum, cnt, mine, sp = 0u;
    for (;;) {
        sum = 0u; cnt = 0u; mine = 0u;
#pragma unroll
        for (unsigned j = 0; j < 16; ++j) { const unsigned c = xb_ld(&bar[XB_XCNT(j)]); sum += c; cnt += (c > 0u) ? 1u : 0u; mine = (j == x) ? c : mine; }
        if (sum == G) break;
        __builtin_amdgcn_s_sleep(1);
        if ((++sp & 255u) == 0u) { if (xb_ld(&bar[XB_TMO])) break; if (sp > XB_SPIN_CAP) { atomicAdd(&bar[XB_TMO], 1u); break; } }
    }
    nloc = mine > 0u ? mine : 1u; nx = cnt > 0u ? cnt : 1u;
}
__device__ __forceinline__ void xcd_barrier(const XcdBarrier& b) {
    asm volatile("s_waitcnt vmcnt(0)" ::: "memory");
    __syncthreads();
    if (threadIdx.x == 0) {
        unsigned* bar = b.bar;
        __builtin_amdgcn_s_waitcnt(0);
        unsigned nloc = xb_ld(&b.st[0]), nx = xb_ld(&b.st[1]);
        if (nloc == 0u) { xcd_barrier_complete(bar, b.x, nloc, nx); __hip_atomic_store(&b.st[0], nloc, __ATOMIC_RELAXED, __HIP_MEMORY_SCOPE_AGENT); __hip_atomic_store(&b.st[1], nx, __ATOMIC_RELAXED, __HIP_MEMORY_SCOPE_AGENT); }
        const unsigned old = xb_add(&bar[XB_XSUB(b.x)], 1u);
        const unsigned gen = old / nloc;
        if (old + 1u == (gen + 1u) * nloc) {
            __builtin_amdgcn_fence(__ATOMIC_RELEASE, "agent");
            asm volatile("s_waitcnt vmcnt(0)" ::: "memory");
            const unsigned og = xb_add(&bar[XB_TOP], 1u);
            const unsigned tg = og / nx;
            if (og + 1u == (tg + 1u) * nx) xb_add(&bar[XB_TOPGEN], 1u);
            else XB_SPIN(xb_ld(&bar[XB_TOPGEN]) == tg, bar);
            __builtin_amdgcn_fence(__ATOMIC_ACQUIRE, "agent");
            xb_add(&bar[XB_XGEN(b.x)], 1u);
            asm volatile("s_waitcnt vmcnt(0)" ::: "memory");
        } else {
            XB_SPIN(xb_ld(&bar[XB_XGEN(b.x)]) == gen, bar);
            __builtin_amdgcn_fence(__ATOMIC_ACQUIRE, "agent");
            asm volatile("s_waitcnt vmcnt(0)" ::: "memory");
        }
    }
    __syncthreads();
}

struct Frame {
    LAS unsigned char* lds;
    int wave, vcu, G;
    float* out;
    unsigned char* ws;
};
#define WSP(T, off) ((T*)(F.ws + (off)))
__device__ __forceinline__ int lane_id() { return (int)__builtin_amdgcn_mbcnt_hi(~0u, __builtin_amdgcn_mbcnt_lo(~0u, 0u)); }
template <int OFF> __device__ __forceinline__ const float* arg_ptr() {
    unsigned long long p; const unsigned long long k = (unsigned long long)__builtin_amdgcn_kernarg_segment_ptr();
    asm volatile("s_load_dwordx2 %0, %1, %2\n\ts_waitcnt lgkmcnt(0)" : "=s"(p) : "s"(k), "i"(OFF));
    return (const float*)p;
}
#define INP(i) arg_ptr<8 * (i)>()

constexpr int WDN_KB_P0A = 56;
constexpr int WGU_KB_P0A = 46;
struct TrIt { const float* src; bf16_t* dst; const float* ks; int ldw, K; };
__device__ __forceinline__ void tr_load(const TrIt& t, f32x4 (&v)[8], int lane) {
    const int kr = lane >> 3, c4 = lane & 7;
#pragma unroll
    for (int i = 0; i < 8; ++i) v[i] = __builtin_nontemporal_load((const GAS f32x4*)(t.src + (size_t)(kr + 8 * i) * t.ldw + 4 * c4));
}
__device__ __forceinline__ void tr_put(const TrIt& t, f32x4 (&v)[8], LAS float* scr, int lane) {
    const int kr = lane >> 3, c4 = lane & 7;
    if (t.ks) {
#pragma unroll
        for (int i = 0; i < 8; ++i) v[i] *= t.ks[kr + 8 * i];
    }
#pragma unroll
    for (int i = 0; i < 8; ++i) { LAS float* d = scr + (kr + 8 * i) * 33 + 4 * c4; d[0] = v[i][0]; d[1] = v[i][1]; d[2] = v[i][2]; d[3] = v[i][3]; }
    LDS_WAIT(); asm volatile("" ::: "memory");
    const int c = lane & 7;
#pragma unroll
    for (int j = 0; j < 4; ++j) { const int n = (lane >> 3) + 8 * j; const LAS float* s = scr + (8 * c) * 33 + n;
        u32x4 o; o.x = cvt_pk_bf16(s[0 * 33], s[1 * 33]); o.y = cvt_pk_bf16(s[2 * 33], s[3 * 33]); o.z = cvt_pk_bf16(s[4 * 33], s[5 * 33]); o.w = cvt_pk_bf16(s[6 * 33], s[7 * 33]);
        *(GAS u32x4*)(t.dst + (size_t)n * t.K + 8 * c) = o; }
    LDS_WAIT(); asm volatile("" ::: "memory");
}
__device__ __forceinline__ TrIt tr_mk(const float* W, int ldw, int c0, bf16_t* WT, int K, int n0, int k0, const float* kscale) {
    TrIt t; t.src = W + (size_t)k0 * ldw + c0; t.dst = WT + (size_t)n0 * K + k0; t.ks = kscale ? kscale + k0 : nullptr; t.ldw = ldw; t.K = K; return t; }
__device__ __forceinline__ TrIt tr_plain(const float* W, int N, bf16_t* WT, int K, int r, int kb0 = 0) { const int nnb = N / 32, nb = r % nnb, kb = kb0 + r / nnb; return tr_mk(W, N, nb * 32, WT, K, nb * 32, kb * 64, nullptr); }
#define TR_RUN(DECODE, first, stride, count, scr) do { const int ln_ = lane_id(); f32x4 va_[8], vb_[8]; TrIt cur_, nxt_; int r_ = (first); \
        if (r_ < (count)) { { const int r = r_; cur_ = (DECODE); } tr_load(cur_, va_, ln_); } \
        for (; r_ < (count); r_ += (stride)) { const bool hn_ = r_ + (stride) < (count); \
            if (hn_) { { const int r = r_ + (stride); nxt_ = (DECODE); } tr_load(nxt_, vb_, ln_); } \
            tr_put(cur_, va_, (scr), ln_); \
            if (hn_) { cur_ = nxt_; _Pragma("unroll") for (int i_ = 0; i_ < 8; ++i_) va_[i_] = vb_[i_]; } } } while (0)
__device__ __forceinline__ TrIt wgu_item(const float* wg, const float* wu, bf16_t* WT, int r, int kb0) {
    const int nb = r % 688, kb = kb0 + r / 688, t = nb >> 3, q = nb & 7;
    return tr_mk((q < 4) ? wg : wu, DFF, t * 128 + (q & 3) * 32, WT, DM, nb * 32, kb * 64, nullptr); }
__device__ __forceinline__ TrIt p0a_decode(Frame& F, int r) {
    constexpr int I_WIN = (NIN / 32) * (DM / 64), I_WQ = 96 * (QL / 64), I_WKV = 128 * (KVL / 64), I_WGU = (NGU / 32) * WGU_KB_P0A;
    if (r < I_WIN) return tr_plain(INP(6), NIN, WSP(bf16_t, WS_WIN), DM, r);
    r -= I_WIN;
    if (r < I_WQ) { const int nb = r % 96, kb = r / 96; int src;
        if (nb < 64) src = (nb >> 2) * 192 + (nb & 3) * 32; else { const int q = nb - 64, T = q >> 3, half = (q >> 2) & 1, hh = q & 3; src = (4 * T + hh) * 192 + 128 + half * 32; }
        return tr_mk(INP(15), NH * 192, src, WSP(bf16_t, WS_WQ), QL, nb * 32, kb * 64, INP(14)); }
    r -= I_WQ;
    if (r < I_WKV) { const int nb = r % 128, kb = r / 128; return tr_mk(INP(17), NH * 256, nb * 32, WSP(bf16_t, WS_WKV), KVL, nb * 32, kb * 64, INP(16)); }
    r -= I_WKV;
    if (r < I_WGU) return wgu_item(INP(23), INP(24), WSP(bf16_t, WS_WGU), r, 0);
    r -= I_WGU;
    if (r < 128 * WDN_KB_P0A) return tr_plain(INP(25), DM, WSP(bf16_t, WS_WDN), DFF, r);
    r -= 128 * WDN_KB_P0A;
    { const int kb = r & 1, jb = (r >> 1) & 3, gate = (r >> 3) & 1, n = r >> 4;
      return tr_mk((gate ? INP(11) : INP(9)) + (size_t)n * 16384, 128, jb * 32, WSP(bf16_t, WS_WG) + (size_t)(n * 256 + gate * 128) * 128, 128, jb * 32, kb * 64, nullptr); }
}
__device__ __forceinline__ void p0a_prep(Frame& F) {
    LAS float* scr = (LAS float*)(F.lds + RING_OFF + F.wave * 16384);
    const int gw = F.vcu * NWAVES + F.wave, NGW = F.G * NWAVES;
    {
        const float* cvec = INP(1); const GAS f32x4* W4 = (const GAS f32x4*)INP(3); f32x4* MP = WSP(f32x4, WS_MODP);
        for (int task = gw; task < 96 * 16; task += NGW) {
            const int cg = task % 96, ks = task / 96;
            f32x4 acc = (f32x4){0.f, 0.f, 0.f, 0.f};
            const GAS f32x4* wp = W4 + (size_t)(ks * 256) * (NMOD / 4) + cg * 64 + lane_id();
#pragma unroll 8
            for (int k = 0; k < 256; ++k) { const float cv = cvec[ks * 256 + k]; const float sv = cv / (1.0f + __expf(-cv)); acc += __builtin_nontemporal_load(wp + (size_t)k * (NMOD / 4)) * sv; }
            MP[(size_t)ks * (NMOD / 4) + cg * 64 + lane_id()] = acc;
        }
    }
    {
        const int* pos = (const int*)INP(2); f32x2* CS = WSP(f32x2, WS_CS);
        for (int idx = gw * 64 + lane_id(); idx < S_ * 32; idx += NGW * 64) {
            const int t = idx >> 5, j = idx & 31;
            const float inv = (float)exp(-(double)j * (9.210340371976184 / 32.0));
            const float ang = (float)pos[t] * inv;
            const double rev = (double)ang * 0.15915494309189535; const double fr = rev - rint(rev);
            const float frf = (float)fr;
            CS[idx] = (f32x2){__builtin_amdgcn_cosf(frf), __builtin_amdgcn_sinf(frf)};
        }
    }
    constexpr int NITEMS = (NIN / 32) * (DM / 64) + 96 * (QL / 64) + 128 * (KVL / 64) + (NGU / 32) * WGU_KB_P0A + 128 * WDN_KB_P0A + 16 * 2 * 4 * 2;
    TR_RUN(p0a_decode(F, r), gw, NGW, NITEMS, scr);
}

__device__ __forceinline__ float mod_col(const float* MP, const float* bmod, int col) {
    float s = bmod[col];
#pragma unroll
    for (int ks = 0; ks < 16; ++ks) s += MP[(size_t)ks * NMOD + col];
    return s;
}
__device__ __forceinline__ void p0b_xn(Frame& F) {
    const float* MP = WSP(float, WS_MODP); const float* bmod = INP(4);
    LAS float* cA = (LAS float*)(F.lds + RING_OFF); LAS float* cB = cA + DM;
    for (int ch = (F.wave * 64 + lane_id()); ch < DM; ch += NWAVES * 64) { const float sh = mod_col(MP, bmod, ch), sc = mod_col(MP, bmod, DM + ch); cA[ch] = INP(5)[ch] * (1.0f + sc); cB[ch] = sh; }
    { float* MOD = WSP(float, WS_MOD); for (int i = blockIdx.x * (NWAVES * 64) + (F.wave * 64 + lane_id()); i < NMOD; i += F.G * NWAVES * 64) MOD[i] = mod_col(MP, bmod, i); }
    __syncthreads();
    const int gw = F.vcu * NWAVES + F.wave, NGW = F.G * NWAVES;
    for (int row = gw; row < S_; row += NGW) {
        const GAS f32x4* xr = (const GAS f32x4*)(INP(0) + (size_t)row * DM) + lane_id();
        f32x4 v[16]; float s = 0.f;
#pragma unroll
        for (int j = 0; j < 16; ++j) { v[j] = xr[64 * j]; s += (v[j][0] * v[j][0] + v[j][1] * v[j][1]) + (v[j][2] * v[j][2] + v[j][3] * v[j][3]); }
        const float rstd = 1.0f / sqrtf(wave_sum(s) * (1.0f / DM) + EPS);
        u32x2* o8 = (u32x2*)(WSP(bf16_t, WS_XN) + (size_t)row * DM) + lane_id();
#pragma unroll
        for (int j = 0; j < 16; ++j) { const f32x4 a = *(const LAS f32x4*)(cA + 4 * (lane_id() + 64 * j)), b = *(const LAS f32x4*)(cB + 4 * (lane_id() + 64 * j));
            const f32x4 h = v[j] * rstd * a + b; u32x2 w; w.x = cvt_pk_bf16(h[0], h[1]); w.y = cvt_pk_bf16(h[2], h[3]); o8[64 * j] = w; }
    }
    __syncthreads();
}

__device__ __forceinline__ void p2_thin(Frame& F) {
    const int gw = F.vcu * NWAVES + F.wave, NGW = F.G * NWAVES;
    const bf16_t* PROJ = WSP(bf16_t, WS_PROJ);
    for (int row = gw; row < S_; row += NGW) {
        const bf16_t* pr = PROJ + (size_t)row * NINP;
        { const u32x4* q = (const u32x4*)(pr + COL_QL) + 2 * lane_id(); float s = 0.f;
#pragma unroll
          for (int i = 0; i < 2; ++i) { const u32x4 w = q[i];
#pragma unroll
            for (int e = 0; e < 4; ++e) { const float a = bflo(w[e]), b = bfhi(w[e]); s += a * a + b * b; } }
          s = wave_sum(s); if (lane_id() == 0) WSP(float, WS_RSQ)[row] = 1.0f / sqrtf(s * (1.0f / QL) + EPS); }
        { const u32x4 w = ((const u32x4*)(pr + COL_KVL))[lane_id()]; float s = 0.f;
#pragma unroll
          for (int e = 0; e < 4; ++e) { const float a = bflo(w[e]), b = bfhi(w[e]); s += a * a + b * b; }
          s = wave_sum(s); if (lane_id() == 0) WSP(float, WS_RSKV)[row] = 1.0f / sqrtf(s * (1.0f / KVL) + EPS); }
        if (lane_id() < 32) { const float x1 = bf1(pr[COL_KR + lane_id()]), x2 = bf1(pr[COL_KR + 32 + lane_id()]); const f32x2 c = WSP(f32x2, WS_CS)[(size_t)row * 32 + lane_id()];
            bf16_t* kp = WSP(bf16_t, WS_KPE) + (size_t)(row >> 6) * 4096 + (row & 63) * 8; const int d = lane_id();
            kp[(d >> 3) * 512 + (d & 7)] = (bf16_t)(cvt_pk_bf16(x1 * c[0] - x2 * c[1], 0.f) & 0xffffu); kp[((32 + d) >> 3) * 512 + (d & 7)] = (bf16_t)(cvt_pk_bf16(x2 * c[0] + x1 * c[1], 0.f) & 0xffffu); }
    }
    const float* cw = INP(7); const float* cb = INP(8);
    for (int item = gw * 64 + lane_id(); item < (S_ / 16) * (LRUW / 8); item += NGW * 64) {
        const int t0 = (item >> 8) * 16, ch0 = (item & 255) * 8;
        const GAS bf16_t* xp = (const GAS bf16_t*)PROJ + (size_t)t0 * NINP + ch0;
        u32x4 xr[19];
#pragma unroll
        for (int i = 0; i < 19; ++i) xr[i] = (t0 - 3 + i >= 0) ? *(const GAS u32x4*)(xp + (ptrdiff_t)(i - 3) * NINP) : (u32x4){0u, 0u, 0u, 0u};
        f32x4 wq[4][2], bq[2];
#pragma unroll
        for (int k = 0; k < 4; ++k) { wq[k][0] = *(const f32x4*)(cw + k * LRUW + ch0); wq[k][1] = *(const f32x4*)(cw + k * LRUW + ch0 + 4); }
        bq[0] = *(const f32x4*)(cb + ch0); bq[1] = *(const f32x4*)(cb + ch0 + 4);
        GAS bf16_t* op = (GAS bf16_t*)WSP(bf16_t, WS_XC) + (size_t)t0 * LRUW + ch0;
#pragma unroll
        for (int i = 0; i < 16; ++i) { f32x4 a0 = bq[0], a1 = bq[1];
#pragma unroll
            for (int k = 0; k < 4; ++k) { const u32x4 w = xr[i + k];
                a0 += wq[k][0] * (f32x4){bflo(w[0]), bfhi(w[0]), bflo(w[1]), bfhi(w[1])}; a1 += wq[k][1] * (f32x4){bflo(w[2]), bfhi(w[2]), bflo(w[3]), bfhi(w[3])}; }
            u32x4 o; o.x = cvt_pk_bf16(a0[0], a0[1]); o.y = cvt_pk_bf16(a0[2], a0[3]); o.z = cvt_pk_bf16(a1[0], a1[1]); o.w = cvt_pk_bf16(a1[2], a1[3]);
            *(GAS u32x4*)(op + (size_t)i * LRUW) = o; }
    }
}

__device__ __forceinline__ int crow(int r, int hi) { return (r & 3) + 8 * (r >> 2) + 4 * hi; }
__device__ __forceinline__ void lru_task(Frame& F, int task) {
    const int lane = lane_id(), r32 = lane & 31, hi = lane >> 5;
    const int cg = task & 3, n = (task >> 2) & 15, chunk = task >> 6;
    const int ch = n * 128 + cg * 32 + r32;
    const bf16_t* WG = WSP(bf16_t, WS_WG) + (size_t)n * 256 * 128;
    bf16x8 Ba[8], Bx[8];
#pragma unroll
    for (int ks = 0; ks < 8; ++ks) { Ba[ks] = *(const bf16x8*)(WG + (size_t)(cg * 32 + r32) * 128 + ks * 16 + hi * 8); Bx[ks] = *(const bf16x8*)(WG + (size_t)(128 + cg * 32 + r32) * 128 + ks * 16 + hi * 8); }
    const float ba = INP(10)[ch], bx = INP(12)[ch];
    const float lam = INP(13)[ch];
    const float nsp8 = -8.0f * log1pf(__expf(-lam));
    bf16_t* HL = WSP(bf16_t, WS_HLOC); bf16_t* PPo = WSP(bf16_t, WS_PP);
    float Sst = 0.f, Qst = 1.f;
    bf16x8 E0, E1;
#pragma unroll
    for (int j = 0; j < 8; ++j) { E0[j] = (8 * hi + j == r32) ? (short)0x3F80 : (short)0; E1[j] = (16 + 8 * hi + j == r32) ? (short)0x3F80 : (short)0; }
    const GAS char* xcb = (const GAS char*)(WSP(bf16_t, WS_XC) + (size_t)chunk * 256 * LRUW + n * 128);
    const unsigned xlo = (unsigned)(r32 * LRUW + hi * 8) * 2u;
    bf16x8 A[8], An[8];
#pragma unroll
    for (int ks = 0; ks < 8; ++ks) A[ks] = *(const GAS bf16x8*)(xcb + xlo + ks * 32);
    for (int ti = 0; ti < 8; ++ti) {
        const int t0 = chunk * 256 + ti * 32;
        if (ti + 1 < 8) {
#pragma unroll
            for (int ks = 0; ks < 8; ++ks) An[ks] = *(const GAS bf16x8*)(xcb + (size_t)(ti + 1) * (32 * LRUW * 2) + xlo + ks * 32);
        }
        f32x16 aa = {}, ax = {}, xt = {};
#pragma unroll
        for (int ks = 0; ks < 8; ++ks) { aa = __builtin_amdgcn_mfma_f32_32x32x16_bf16(A[ks], Ba[ks], aa, 0, 0, 0); ax = __builtin_amdgcn_mfma_f32_32x32x16_bf16(A[ks], Bx[ks], ax, 0, 0, 0); }
        { const bf16x8 xa0 = (cg == 0) ? A[0] : (cg == 1) ? A[2] : (cg == 2) ? A[4] : A[6], xa1 = (cg == 0) ? A[1] : (cg == 1) ? A[3] : (cg == 2) ? A[5] : A[7];
          xt = __builtin_amdgcn_mfma_f32_32x32x16_bf16(xa0, E0, xt, 0, 0, 0); xt = __builtin_amdgcn_mfma_f32_32x32x16_bf16(xa1, E1, xt, 0, 0, 0); }
        float av[16], uv[16];
#pragma unroll
        for (int r = 0; r < 16; ++r) {
            const float xv = xt[r];
            const float rg = sigmoidf_(aa[r] + ba), ig = sigmoidf_(ax[r] + bx);
            const float la = nsp8 * rg, x2 = 2.0f * la;
            av[r] = __expf(la);
            const float poly = -x2 * (1.0f + x2 * (0.5f + x2 * (0.16666667f + x2 * (0.041666668f + x2 * (0.0083333338f + x2 * 0.0013888889f)))));
            const float om = (x2 > -0.25f) ? poly : (1.0f - __expf(x2));
            uv[r] = __builtin_amdgcn_sqrtf(om) * (ig * xv);
        }
        float Pg[4], Hg[4];
#pragma unroll
        for (int g = 0; g < 4; ++g) { float P = 1.f, Hh = 0.f;
#pragma unroll
            for (int i = 0; i < 4; ++i) { const int r = 4 * g + i; Hh = av[r] * Hh + uv[r]; P *= av[r]; uv[r] = Hh; av[r] = P; }
            Pg[g] = P; Hg[g] = Hh; }
#pragma unroll
        for (int g = 0; g < 4; ++g) {
            const float Po = __shfl_xor(Pg[g], 32), Ho = __shfl_xor(Hg[g], 32);
            const float P0 = hi ? Po : Pg[g], H0 = hi ? Ho : Hg[g], P1 = hi ? Pg[g] : Po, H1 = hi ? Hg[g] : Ho;
            const float S0 = Sst, Q0 = Qst; Sst = P0 * Sst + H0; Qst = Qst * P0;
            const float S1 = Sst, Q1 = Qst; Sst = P1 * Sst + H1; Qst = Qst * P1;
            const float cS = hi ? S1 : S0, cQ = hi ? Q1 : Q0;
#pragma unroll
            for (int i = 0; i < 4; ++i) { const int r = 4 * g + i; const size_t o = (size_t)(t0 + crow(r, hi)) * LRUW + ch;
                HL[o] = (bf16_t)(cvt_pk_bf16(uv[r] + av[r] * cS, 0.f) & 0xffffu); PPo[o] = (bf16_t)(cvt_pk_bf16(av[r] * cQ, 0.f) & 0xffffu); }
        }
#pragma unroll
        for (int ks = 0; ks < 8; ++ks) A[ks] = An[ks];
    }
    if (hi == 0) { WSP(float, WS_CA)[chunk * LRUW + ch] = Qst; WSP(float, WS_CH)[chunk * LRUW + ch] = Sst; }
}

#define KSLOT 24576
#define VSLOT 16384
constexpr int ATT_K0 = 0, ATT_V0 = 2 * KSLOT, ATT_WS = 2 * KSLOT + 3 * VSLOT, ATT_QPE = ATT_WS + NWAVES * 256, ATT_LDS = ATT_QPE + NWAVES * 4096;
static_assert(ATT_LDS <= LDSCTL_OFF, "attention LDS");
__device__ __forceinline__ int v_rd_base(int lane) { return ((lane & 3) << 3) | (((lane >> 2) & 3) << 6) | (((lane >> 4) & 1) << 5) | (((lane >> 5) & 1) << 8); }
constexpr int v_rd_off(int d0, int ks, int half) { return d0 * 512 + ks * 4096 + half * 2048; }
template <int OFF> __device__ __forceinline__ s16x4 tr_read(int vb) { s16x4 r; asm volatile("ds_read_b64_tr_b16 %0, %1 offset:%2" : "=&v"(r) : "v"(vb), "i"(OFF) : "memory"); return r; }
__device__ __forceinline__ void glds16s(const void* sbase, unsigned voff, unsigned lds_dst) {
    unsigned keep;
    asm volatile("s_mov_b32 %0, m0\n\ts_mov_b32 m0, %3\n\ts_nop 0\n\tglobal_load_lds_dwordx4 %1, %2\n\ts_mov_b32 m0, %0" : "=&s"(keep) : "v"(voff), "s"(sbase), "s"(lds_dst) : "memory");
}
struct VFr { s16x4 l0, h0, l1, h1, l2, h2, l3, h3; };
template <int D0> __device__ __forceinline__ void v_rd(VFr& f, int vb) {
    f.l0 = tr_read<v_rd_off(D0, 0, 0)>(vb); f.h0 = tr_read<v_rd_off(D0, 0, 1)>(vb); f.l1 = tr_read<v_rd_off(D0, 1, 0)>(vb); f.h1 = tr_read<v_rd_off(D0, 1, 1)>(vb);
    f.l2 = tr_read<v_rd_off(D0, 2, 0)>(vb); f.h2 = tr_read<v_rd_off(D0, 2, 1)>(vb); f.l3 = tr_read<v_rd_off(D0, 3, 0)>(vb); f.h3 = tr_read<v_rd_off(D0, 3, 1)>(vb);
}
__device__ __forceinline__ void v_mma(f32x16& od, const VFr& f, bf16x8 pa0, bf16x8 pa1, bf16x8 pa2, bf16x8 pa3) {
#define PK(L, H) (bf16x8){L[0], L[1], L[2], L[3], H[0], H[1], H[2], H[3]}
    od = __builtin_amdgcn_mfma_f32_32x32x16_bf16(pa0, PK(f.l0, f.h0), od, 0, 0, 0);
    od = __builtin_amdgcn_mfma_f32_32x32x16_bf16(pa1, PK(f.l1, f.h1), od, 0, 0, 0);
    od = __builtin_amdgcn_mfma_f32_32x32x16_bf16(pa2, PK(f.l2, f.h2), od, 0, 0, 0);
    od = __builtin_amdgcn_mfma_f32_32x32x16_bf16(pa3, PK(f.l3, f.h3), od, 0, 0, 0);
#undef PK
}
__device__ __forceinline__ void pv_tile(f32x16 (&o)[4], int vb, bf16x8 pa0, bf16x8 pa1, bf16x8 pa2, bf16x8 pa3) {
    VFr fa, fb;
    v_rd<0>(fa, vb); v_rd<1>(fb, vb);
    asm volatile("s_waitcnt lgkmcnt(8)" ::: "memory"); __builtin_amdgcn_sched_barrier(0);
    v_mma(o[0], fa, pa0, pa1, pa2, pa3); __builtin_amdgcn_sched_barrier(0);
    v_rd<2>(fa, vb);
    asm volatile("s_waitcnt lgkmcnt(8)" ::: "memory"); __builtin_amdgcn_sched_barrier(0);
    v_mma(o[1], fb, pa0, pa1, pa2, pa3); __builtin_amdgcn_sched_barrier(0);
    v_rd<3>(fb, vb);
    asm volatile("s_waitcnt lgkmcnt(8)" ::: "memory"); __builtin_amdgcn_sched_barrier(0);
    v_mma(o[2], fa, pa0, pa1, pa2, pa3); __builtin_amdgcn_sched_barrier(0);
    asm volatile("s_waitcnt lgkmcnt(0)" ::: "memory"); __builtin_amdgcn_sched_barrier(0);
    v_mma(o[3], fb, pa0, pa1, pa2, pa3); __builtin_amdgcn_sched_barrier(0);
}
__device__ __forceinline__ void attn_unit(Frame& F, int h, int qb) {
    const int lane = lane_id(), wid = F.wave, r32 = lane & 31, hi = lane >> 5;
    const bool lag = wid >= 4;
    const bf16_t* QN = WSP(bf16_t, WS_QN); const bf16_t* QPE = WSP(bf16_t, WS_QPE);
    LAS unsigned char* lds = F.lds + RING_OFF;
    LAS float* wsf = (LAS float*)(lds + ATT_WS) + wid * 64;
    const int q0 = qb * 256 + wid * 32;
    const int NT = 4 * qb + 4, my_nt = 4 * qb + (wid >> 1) + 1;
    const char* ktb0 = (const char*)WSP(bf16_t, WS_KT) + (size_t)h * (128 * 16384) + wid * 1024;
    const char* vtb0 = (const char*)WSP(bf16_t, WS_VT) + (size_t)h * (128 * 16384) + wid * 1024;
    const char* kpb0 = (const char*)WSP(bf16_t, WS_KPE) + wid * 1024;
    const unsigned lo16 = (unsigned)lane * 16u;
    const unsigned ldsK = (unsigned)(uintptr_t)(lds + ATT_K0), ldsV = (unsigned)(uintptr_t)(lds + ATT_V0);
#define ATT_DMA1(p, tile, kslot, vslot) do { \
        if ((p) == 0) glds16s(ktb0 + (size_t)(tile) * 16384, lo16, ldsK + (kslot) * KSLOT + wid * 1024); \
        if ((p) == 1) glds16s(ktb0 + (size_t)(tile) * 16384 + 8192, lo16, ldsK + (kslot) * KSLOT + wid * 1024 + 8192); \
        if ((p) == 2) glds16s(kpb0 + (size_t)(tile) * 8192, lo16, ldsK + (kslot) * KSLOT + wid * 1024 + 16384); \
        if ((p) == 3) glds16s(vtb0 + (size_t)(tile) * 16384, lo16, ldsV + (vslot) * VSLOT + wid * 1024); \
        if ((p) == 4) glds16s(vtb0 + (size_t)(tile) * 16384 + 8192, lo16, ldsV + (vslot) * VSLOT + wid * 1024 + 8192); } while (0)
#define ATT_DMA(tile, kslot, vslot) do { ATT_DMA1(0, tile, kslot, vslot); ATT_DMA1(1, tile, kslot, vslot); ATT_DMA1(2, tile, kslot, vslot); ATT_DMA1(3, tile, kslot, vslot); ATT_DMA1(4, tile, kslot, vslot); } while (0)
    asm volatile("s_waitcnt lgkmcnt(0)" ::: "memory"); __builtin_amdgcn_s_barrier(); asm volatile("" ::: "memory");
    ATT_DMA(0, 0, 0);
    bf16x8 qr[8];
#pragma unroll
    for (int d0 = 0; d0 < 8; ++d0) qr[d0] = *(const bf16x8*)(QN + (size_t)(q0 + r32) * 2048 + h * 128 + d0 * 16 + hi * 8);
    LAS unsigned char* qpl = lds + ATT_QPE + wid * 4096 + lane * 16;
#pragma unroll
    for (int d0 = 0; d0 < 4; ++d0) *(LAS bf16x8*)(qpl + d0 * 1024) = *(const bf16x8*)(QPE + (size_t)(q0 + r32) * 1024 + h * 64 + d0 * 16 + hi * 8);
    f32x16 o[4] = {}; float m_reg = -1e30f, l_reg = 0.f;
    bf16x8 pa0 = {}, pa1 = {}, pa2 = {}, pa3 = {};
    const int vbase = (int)(uintptr_t)(lds + ATT_V0) + v_rd_base(lane);
    int vs_cur = 0, vs_prev = 0;
    for (int j = 0; j < NT; ++j) {
        asm volatile("s_waitcnt vmcnt(0)" ::: "memory"); __builtin_amdgcn_s_barrier(); asm volatile("" ::: "memory");
        const int vs_next = (vs_cur == 2 * VSLOT) ? 0 : vs_cur + VSLOT;
        const int vsl = (vs_next == 0) ? 0 : (vs_next == VSLOT ? 1 : 2); const bool pre = (j + 1 < NT);
        if (pre && j >= my_nt) ATT_DMA(j + 1, (j + 1) & 1, vsl);
        if (lag && j >= 1 && j - 1 < my_nt) pv_tile(o, vbase + vs_prev, pa0, pa1, pa2, pa3);
        if (j < my_nt) {
            f32x16 p0 = {}, p1 = {};
            const LAS unsigned char* kb = lds + ATT_K0 + (j & 1) * KSLOT + hi * 1024 + r32 * 16;
            bf16x8 kf[4][2], qpf[4];
#define KLD(s) do { kf[(s) & 3][0] = *(const LAS bf16x8*)(kb + (s) * 2048); kf[(s) & 3][1] = *(const LAS bf16x8*)(kb + (s) * 2048 + 512); } while (0)
            __builtin_amdgcn_sched_barrier(0);
            KLD(0); KLD(1); KLD(2); KLD(3);
            __builtin_amdgcn_sched_barrier(0);
#pragma unroll
            for (int s = 0; s < 12; ++s) {
                if (s == 4) {
#pragma unroll
                    for (int d = 0; d < 4; ++d) qpf[d] = *(const LAS bf16x8*)(qpl + d * 1024);
                }
                const bf16x8 qf = (s < 8) ? qr[s & 7] : qpf[s & 3];
                p0 = __builtin_amdgcn_mfma_f32_32x32x16_bf16(kf[s & 3][0], qf, p0, 0, 0, 0); p1 = __builtin_amdgcn_mfma_f32_32x32x16_bf16(kf[s & 3][1], qf, p1, 0, 0, 0);
                __builtin_amdgcn_sched_barrier(0);
                if (s + 4 < 12) KLD(s + 4);
                if (pre && (s & 1) == 1 && s < 10) ATT_DMA1(s >> 1, j + 1, (j + 1) & 1, vsl);
                __builtin_amdgcn_sched_barrier(0);
            }
#undef KLD
            float mx = fmaxf(p0[0], p1[0]);
#pragma unroll
            for (int r = 1; r < 16; ++r) mx = fmaxf(fmaxf(mx, p0[r]), p1[r]);
            { auto rr = __builtin_amdgcn_permlane32_swap(__float_as_uint(mx), __float_as_uint(mx), false, false); mx = fmaxf(__uint_as_float(rr[0]), __uint_as_float(rr[1])); }
            if (__any(mx - m_reg > 8.0f)) {
                const float mn = fmaxf(m_reg, mx); const float alpha = __builtin_amdgcn_exp2f(m_reg - mn); m_reg = mn; l_reg *= alpha;
                if (hi == 0) wsf[r32] = alpha; asm volatile("s_waitcnt lgkmcnt(0)" ::: "memory");
#pragma unroll
                for (int d = 0; d < 4; ++d)
#pragma unroll
                    for (int r = 0; r < 16; ++r) o[d][r] *= wsf[crow(r, hi)];
            }
            float ps = 0.f;
#pragma unroll
            for (int r = 0; r < 16; ++r) { p0[r] = __builtin_amdgcn_exp2f(p0[r] - m_reg); p1[r] = __builtin_amdgcn_exp2f(p1[r] - m_reg); ps += p0[r] + p1[r]; }
            { auto rr = __builtin_amdgcn_permlane32_swap(__float_as_uint(ps), __float_as_uint(ps), false, false); ps = __uint_as_float(rr[0]) + __uint_as_float(rr[1]); }
            l_reg += ps;
#define PK4(P, BASE, OUT) do { unsigned a0 = cvt_pk_bf16(P[BASE + 0], P[BASE + 1]), a1 = cvt_pk_bf16(P[BASE + 2], P[BASE + 3]);   \
    unsigned b0_ = cvt_pk_bf16(P[BASE + 4], P[BASE + 5]), b1_ = cvt_pk_bf16(P[BASE + 6], P[BASE + 7]);                              \
    auto r0 = __builtin_amdgcn_permlane32_swap(a0, b0_, false, false); auto r1 = __builtin_amdgcn_permlane32_swap(a1, b1_, false, false); \
    u32x4 w = {r0[0], r1[0], r0[1], r1[1]}; OUT = __builtin_bit_cast(bf16x8, w); } while (0)
            PK4(p0, 0, pa0); PK4(p0, 8, pa1); PK4(p1, 0, pa2); PK4(p1, 8, pa3);
#undef PK4
            if (!lag) pv_tile(o, vbase + vs_cur, pa0, pa1, pa2, pa3);
        }
        vs_prev = vs_cur; vs_cur = vs_next;
    }
    if (lag && NT - 1 < my_nt) pv_tile(o, vbase + vs_prev, pa0, pa1, pa2, pa3);
    if (hi == 0) wsf[32 + r32] = l_reg;
    asm volatile("s_waitcnt lgkmcnt(0)" ::: "memory");
    bf16_t* Yo = WSP(bf16_t, WS_Y) + (size_t)q0 * DM + LRUW + h * 128;
#pragma unroll
    for (int r = 0; r < 16; ++r) { const int orow = crow(r, hi); const float rl = __builtin_amdgcn_rcpf(wsf[32 + orow]);
#pragma unroll
        for (int d0 = 0; d0 < 4; ++d0) Yo[(size_t)orow * DM + d0 * 32 + r32] = (bf16_t)(cvt_pk_bf16(o[d0][r] * rl, 0.f) & 0xffffu); }
#undef ATT_DMA
#undef ATT_DMA1
}
__device__ __forceinline__ void attn_phase(Frame& F) {
    for (int uidx = F.vcu; uidx < 256; uidx += F.G) {
        const int h = uidx >> 4, s = uidx & 15;
        attn_unit(F, h, s);
        attn_unit(F, h, 31 - s);
    }
    asm volatile("s_waitcnt vmcnt(0) lgkmcnt(0)" ::: "memory"); __builtin_amdgcn_s_barrier();
}

__device__ __forceinline__ void p5_finalize(Frame& F) {
    LAS float* carry = (LAS float*)(F.lds + RING_OFF);
    const float* CA = WSP(float, WS_CA); const float* CH = WSP(float, WS_CH);
    const bf16_t* HL = WSP(bf16_t, WS_HLOC); const bf16_t* PPi = WSP(bf16_t, WS_PP); const bf16_t* PROJ = WSP(bf16_t, WS_PROJ);
    bf16_t* Y = WSP(bf16_t, WS_Y);
    const float* g_lru = INP(18); const float* g_mla = INP(19);
    for (int rb = F.vcu; rb < S_ / 32; rb += F.G) {
        const int chunk = rb >> 3;
        __syncthreads();
        { const int c4 = (F.wave * 64 + lane_id()) * 4; f32x4 st = (f32x4){0.f, 0.f, 0.f, 0.f};
          for (int c = 0; c < chunk; c += 8) {
              f32x4 a[8], hh[8];
#pragma unroll
              for (int i = 0; i < 8; ++i) { const int cc = (c + i < chunk) ? c + i : c; a[i] = *(const GAS f32x4*)((const GAS float*)CA + cc * LRUW + c4); hh[i] = *(const GAS f32x4*)((const GAS float*)CH + cc * LRUW + c4); }
#pragma unroll
              for (int i = 0; i < 8; ++i) if (c + i < chunk) st = a[i] * st + hh[i]; }
          *(LAS f32x4*)(carry + c4) = st; }
        __syncthreads();
        for (int rr = 0; rr < 4; rr += 2) {
            const int row0 = rb * 32 + F.wave * 4 + rr, ln = lane_id();
            u32x4 hl[2][4], pp[2][4], gr[2][4], ov[2][4];
#pragma unroll
            for (int q = 0; q < 2; ++q)
#pragma unroll
                for (int j = 0; j < 4; ++j) { const int c0 = 8 * (ln + 64 * j); const size_t row = (size_t)(row0 + q);
                    hl[q][j] = *(const GAS u32x4*)((const GAS bf16_t*)HL + row * LRUW + c0); pp[q][j] = *(const GAS u32x4*)((const GAS bf16_t*)PPi + row * LRUW + c0);
                    gr[q][j] = *(const GAS u32x4*)((const GAS bf16_t*)PROJ + row * NINP + COL_GR + c0); ov[q][j] = *(const GAS u32x4*)((const GAS bf16_t*)Y + row * DM + LRUW + c0); }
#pragma unroll
            for (int q = 0; q < 2; ++q) {
                const size_t row = (size_t)(row0 + q);
                float y[4][8]; float ss = 0.f, s2 = 0.f;
#pragma unroll
                for (int j = 0; j < 4; ++j) { const int c0 = 8 * (ln + 64 * j);
                    const f32x4 ca = *(const LAS f32x4*)(carry + c0), cb = *(const LAS f32x4*)(carry + c0 + 4);
#pragma unroll
                    for (int e = 0; e < 4; ++e) { const float c_lo = (e < 2) ? ca[2 * e] : cb[2 * e - 4], c_hi = (e < 2) ? ca[2 * e + 1] : cb[2 * e - 3];
                        const float h0 = bflo(hl[q][j][e]) + bflo(pp[q][j][e]) * c_lo, h1 = bfhi(hl[q][j][e]) + bfhi(pp[q][j][e]) * c_hi;
                        const float y0 = h0 * gelu_tanh(bflo(gr[q][j][e])), y1 = h1 * gelu_tanh(bfhi(gr[q][j][e]));
                        y[j][2 * e] = y0; y[j][2 * e + 1] = y1; ss += y0 * y0 + y1 * y1;
                        const float a = bflo(ov[q][j][e]), b = bfhi(ov[q][j][e]); s2 += a * a + b * b; } }
                const float rstd = 1.0f / sqrtf(wave_sum(ss) * (1.0f / LRUW) + EPS), rstd2 = 1.0f / sqrtf(wave_sum(s2) * (1.0f / LRUW) + EPS);
#pragma unroll
                for (int j = 0; j < 4; ++j) { const int c0 = 8 * (ln + 64 * j); const f32x4 g0 = *(const f32x4*)(g_lru + c0), g1 = *(const f32x4*)(g_lru + c0 + 4), m0 = *(const f32x4*)(g_mla + c0), m1 = *(const f32x4*)(g_mla + c0 + 4);
                    u32x4 w; w.x = cvt_pk_bf16(y[j][0] * rstd * g0[0], y[j][1] * rstd * g0[1]); w.y = cvt_pk_bf16(y[j][2] * rstd * g0[2], y[j][3] * rstd * g0[3]);
                    w.z = cvt_pk_bf16(y[j][4] * rstd * g1[0], y[j][5] * rstd * g1[1]); w.w = cvt_pk_bf16(y[j][6] * rstd * g1[2], y[j][7] * rstd * g1[3]);
                    *(GAS u32x4*)((GAS bf16_t*)Y + row * DM + c0) = w;
                    u32x4 v; v.x = cvt_pk_bf16(bflo(ov[q][j][0]) * rstd2 * m0[0], bfhi(ov[q][j][0]) * rstd2 * m0[1]); v.y = cvt_pk_bf16(bflo(ov[q][j][1]) * rstd2 * m0[2], bfhi(ov[q][j][1]) * rstd2 * m0[3]);
                    v.z = cvt_pk_bf16(bflo(ov[q][j][2]) * rstd2 * m1[0], bfhi(ov[q][j][2]) * rstd2 * m1[1]); v.w = cvt_pk_bf16(bflo(ov[q][j][3]) * rstd2 * m1[2], bfhi(ov[q][j][3]) * rstd2 * m1[3]);
                    *(GAS u32x4*)((GAS bf16_t*)Y + row * DM + LRUW + c0) = v; }
            }
        }
    }
    __syncthreads();
}

__device__ __forceinline__ void p7_mid(Frame& F) {
    const float* MOD = WSP(float, WS_MOD);
    LAS float* cC = (LAS float*)(F.lds + RING_OFF); LAS float* cD = cC + DM; LAS float* cE = cD + DM;
    for (int ch = (F.wave * 64 + lane_id()); ch < DM; ch += NWAVES * 64) { cC[ch] = MOD[2 * DM + ch] * INP(21)[ch]; cD[ch] = INP(22)[ch] * (1.0f + MOD[4 * DM + ch]); cE[ch] = MOD[3 * DM + ch]; }
    __syncthreads();
    const int gw = F.vcu * NWAVES + F.wave, NGW = F.G * NWAVES;
    const bf16_t* YO = WSP(bf16_t, WS_YO); const float* xin = INP(0);
    for (int row = gw; row < S_; row += NGW) {
        u32x4 yv[8]; float s = 0.f;
#pragma unroll
        for (int j = 0; j < 8; ++j) { yv[j] = *(const u32x4*)(YO + (size_t)row * DM + 8 * (lane_id() + 64 * j));
#pragma unroll
            for (int e = 0; e < 4; ++e) { const float a = bflo(yv[j][e]), b = bfhi(yv[j][e]); s += a * a + b * b; } }
        const float rstd1 = 1.0f / sqrtf(wave_sum(s) * (1.0f / DM) + EPS);
        if (lane_id() == 0) WSP(float, WS_RS1)[row] = rstd1;
        f32x4 x1[8][2]; float s2 = 0.f;
#pragma unroll
        for (int j = 0; j < 8; ++j) { const int c0 = 8 * (lane_id() + 64 * j);
            const f32x4 xa = __builtin_nontemporal_load((const GAS f32x4*)(xin + (size_t)row * DM + c0)), xb = __builtin_nontemporal_load((const GAS f32x4*)(xin + (size_t)row * DM + c0 + 4));
            const f32x4 ca = *(const LAS f32x4*)(cC + c0), cb = *(const LAS f32x4*)(cC + c0 + 4);
            const f32x4 ya = (f32x4){bflo(yv[j][0]), bfhi(yv[j][0]), bflo(yv[j][1]), bfhi(yv[j][1])}, yb = (f32x4){bflo(yv[j][2]), bfhi(yv[j][2]), bflo(yv[j][3]), bfhi(yv[j][3])};
            const f32x4 a = xa + ca * ya * rstd1, b = xb + cb * yb * rstd1;
            x1[j][0] = a; x1[j][1] = b;
            s2 += (a[0] * a[0] + a[1] * a[1]) + (a[2] * a[2] + a[3] * a[3]) + (b[0] * b[0] + b[1] * b[1]) + (b[2] * b[2] + b[3] * b[3]); }
        const float rstd2 = 1.0f / sqrtf(wave_sum(s2) * (1.0f / DM) + EPS);
#pragma unroll
        for (int j = 0; j < 8; ++j) { const int c0 = 8 * (lane_id() + 64 * j);
            const f32x4 da = *(const LAS f32x4*)(cD + c0), db = *(const LAS f32x4*)(cD + c0 + 4), ea = *(const LAS f32x4*)(cE + c0), eb = *(const LAS f32x4*)(cE + c0 + 4);
            const f32x4 ha = x1[j][0] * rstd2 * da + ea, hb = x1[j][1] * rstd2 * db + eb;
            u32x4 w; w.x = cvt_pk_bf16(ha[0], ha[1]); w.y = cvt_pk_bf16(ha[2], ha[3]); w.z = cvt_pk_bf16(hb[0], hb[1]); w.w = cvt_pk_bf16(hb[2], hb[3]);
            *(u32x4*)(WSP(bf16_t, WS_XN) + (size_t)row * DM + c0) = w; }
    }
    __syncthreads();
}

__device__ __forceinline__ void p10_final(Frame& F) {
    const float* MOD = WSP(float, WS_MOD);
    LAS float* cF = (LAS float*)(F.lds + RING_OFF); LAS float* cC = cF + DM;
    for (int ch = (F.wave * 64 + lane_id()); ch < DM; ch += NWAVES * 64) { cF[ch] = MOD[5 * DM + ch] * INP(26)[ch]; cC[ch] = MOD[2 * DM + ch] * INP(21)[ch]; }
    __syncthreads();
    const int gw = F.vcu * NWAVES + F.wave, NGW = F.G * NWAVES;
    const GAS bf16_t* FB = (const GAS bf16_t*)WSP(bf16_t, WS_F); const GAS bf16_t* YO = (const GAS bf16_t*)WSP(bf16_t, WS_YO); const GAS float* X = (const GAS float*)INP(0);
    for (int row = gw; row < S_; row += NGW) {
        u32x4 fv[8]; float s = 0.f;
#pragma unroll
        for (int j = 0; j < 8; ++j) { fv[j] = *(const GAS u32x4*)(FB + (size_t)row * DM + 8 * (lane_id() + 64 * j));
#pragma unroll
            for (int e = 0; e < 4; ++e) { const float a = bflo(fv[j][e]), b = bfhi(fv[j][e]); s += a * a + b * b; } }
        const float rstd = 1.0f / sqrtf(wave_sum(s) * (1.0f / DM) + EPS);
        const float rstd1 = WSP(float, WS_RS1)[row];
#pragma unroll
        for (int j = 0; j < 8; ++j) { const int c0 = 8 * (lane_id() + 64 * j);
            const f32x4 xa = __builtin_nontemporal_load((const GAS f32x4*)(X + (size_t)row * DM + c0)), xb = __builtin_nontemporal_load((const GAS f32x4*)(X + (size_t)row * DM + c0 + 4));
            const f32x4 ca = *(const LAS f32x4*)(cF + c0), cb = *(const LAS f32x4*)(cF + c0 + 4), da = *(const LAS f32x4*)(cC + c0), db = *(const LAS f32x4*)(cC + c0 + 4);
            const f32x4 fa = (f32x4){bflo(fv[j][0]), bfhi(fv[j][0]), bflo(fv[j][1]), bfhi(fv[j][1])}, fb = (f32x4){bflo(fv[j][2]), bfhi(fv[j][2]), bflo(fv[j][3]), bfhi(fv[j][3])};
            const u32x4 yw = *(const GAS u32x4*)(YO + (size_t)row * DM + c0);
            const f32x4 ya = (f32x4){bflo(yw[0]), bfhi(yw[0]), bflo(yw[1]), bfhi(yw[1])}, yb = (f32x4){bflo(yw[2]), bfhi(yw[2]), bflo(yw[3]), bfhi(yw[3])};
            const f32x4 x1a = xa + da * ya * rstd1, x1b = xb + db * yb * rstd1;
            GAS float* op = (GAS float*)F.out + (size_t)row * DM + c0;
            __builtin_nontemporal_store(x1a + ca * fa * rstd, (GAS f32x4*)op); __builtin_nontemporal_store(x1b + cb * fb * rstd, (GAS f32x4*)(op + 4));
            if ((j & 3) == 3) __builtin_amdgcn_sched_barrier(0); }
    }
}

constexpr int NPH = 12;
struct Args { const float* in[27]; float* out; unsigned char* ws; int ph_lo, ph_hi, li, pad; };

template <class Epi, bool ALIGN>
__device__ __forceinline__ void run_gemm(Frame& F, const pg8::Gemm& g, const Epi& E) {
    pg8::StaticOrder S; S.init(g.M, g.N, F.G, (int)blockIdx.x);
    pg8::gemm_phase<Epi, pg8::StaticOrder, ALIGN>(F.lds + RING_OFF, g, S, E);
}

__global__ void __launch_bounds__(NWAVES * 64, 2) mk_fwd(Args args) {
    extern __shared__ __attribute__((aligned(16))) unsigned char lds_raw[];
    Frame F;
    F.lds = (LAS unsigned char*)lds_raw;
    F.wave = __builtin_amdgcn_readfirstlane((int)threadIdx.x >> 6);
    F.G = gridDim.x; { const int bx = blockIdx.x; F.vcu = (F.G % 8 == 0) ? (bx % 8) * (F.G / 8) + bx / 8 : bx; }
    F.out = args.out; F.ws = args.ws;
    unsigned* bar_region = (unsigned*)(F.ws + WS_CTL) + CW_BAR + args.li * 4096;
    XcdBarrier bar = xcd_barrier_post(bar_region, bar_region + XCD_BAR_WORDS + 2 * blockIdx.x);
#define GRID_BAR() xcd_barrier(bar)
    const int lo = args.ph_lo, hi = args.ph_hi;
#define IN(k) (lo <= (k) && (k) < hi)
#define BOTH(k) (IN(k) && IN((k) + 1))

    if (IN(0)) { p0a_prep(F); if (BOTH(0)) GRID_BAR(); }
    if (IN(1)) { p0b_xn(F); if (BOTH(1)) GRID_BAR(); }
    if (IN(2)) {
        pg8::Gemm g{WSP(bf16_t, WS_XN), WSP(bf16_t, WS_WIN), S_, NINP, DM, DM, DM};
        pg8::EpiStore E{WSP(bf16_t, WS_PROJ), NINP};
        run_gemm<pg8::EpiStore, true>(F, g, E);
        const int first = ((S_ / 256) * (NINP / 256)) % F.G;
        if ((int)blockIdx.x >= first) { LAS float* scr = (LAS float*)(F.lds + RING_OFF + F.wave * 16384); const int lw = ((int)blockIdx.x - first) * NWAVES + F.wave, nlw = (F.G - first) * NWAVES;
            const float* wsrc = INP(20); TR_RUN(tr_plain(wsrc, DM, WSP(bf16_t, WS_WOUT), DM, r), lw, nlw, 128 * (DM / 64), scr); }
        if (BOTH(2)) GRID_BAR();
    }
    if (IN(3)) { p2_thin(F); if (BOTH(3)) GRID_BAR(); }
    if (IN(4)) {
        { pg8::Gemm g{WSP(bf16_t, WS_PROJ) + COL_QL, WSP(bf16_t, WS_WQ), S_, NH * 192, QL, NINP, QL};
          pg8::EpiQ E{WSP(bf16_t, WS_QN), WSP(bf16_t, WS_QPE), WSP(float, WS_RSQ), WSP(f32x2, WS_CS)};
          run_gemm<pg8::EpiQ, true>(F, g, E);
          const int first = ((S_ / 256) * (NH * 192 / 256)) % F.G;
          if (first > 0 && (int)blockIdx.x >= first) { LAS float* scr = (LAS float*)(F.lds + RING_OFF + F.wave * 16384); const int lw = ((int)blockIdx.x - first) * NWAVES + F.wave, nlw = (F.G - first) * NWAVES;
              const float* wg = INP(23); const float* wu = INP(24); TR_RUN(wgu_item(wg, wu, WSP(bf16_t, WS_WGU), r, WGU_KB_P0A), lw, nlw, 688 * (64 - WGU_KB_P0A), scr); }
          else if (first == 0) { LAS float* scr = (LAS float*)(F.lds + RING_OFF + F.wave * 16384); const float* wg = INP(23); const float* wu = INP(24);
              TR_RUN(wgu_item(wg, wu, WSP(bf16_t, WS_WGU), r, WGU_KB_P0A), F.vcu * NWAVES + F.wave, F.G * NWAVES, 688 * (64 - WGU_KB_P0A), scr); }
          __syncthreads(); }
        { pg8::Gemm g{WSP(bf16_t, WS_PROJ) + COL_KVL, WSP(bf16_t, WS_WKV), S_, NH * 256, KVL, NINP, KVL};
          pg8::EpiKV E{WSP(bf16_t, WS_KT), WSP(bf16_t, WS_VT), WSP(float, WS_RSKV)};
          run_gemm<pg8::EpiKV, true>(F, g, E); }
        { const int gw = F.vcu * NWAVES + F.wave, NGW = F.G * NWAVES;
          for (int task = gw; task < 32 * 16 * 4; task += NGW) lru_task(F, task); }
        if (BOTH(4)) GRID_BAR();
    }
    if (IN(5)) { attn_phase(F); if (BOTH(5)) GRID_BAR(); }
    if (IN(6)) { p5_finalize(F); if (BOTH(6)) GRID_BAR(); }
    if (IN(7)) {
        pg8::Gemm g{WSP(bf16_t, WS_Y), WSP(bf16_t, WS_WOUT), S_, DM, DM, DM, DM};
        pg8::EpiStore E{WSP(bf16_t, WS_YO), DM};
        run_gemm<pg8::EpiStore, true>(F, g, E);
        if (BOTH(7)) GRID_BAR();
    }
    if (IN(8)) { p7_mid(F); if (BOTH(8)) GRID_BAR(); }
    if (IN(9)) {
        pg8::Gemm g{WSP(bf16_t, WS_XN), WSP(bf16_t, WS_WGU), S_, NGU, DM, DM, DM};
        pg8::EpiGU E{WSP(bf16_t, WS_H)};
        run_gemm<pg8::EpiGU, true>(F, g, E);
        const int first = ((S_ / 256) * (NGU / 256)) % F.G;
        if ((int)blockIdx.x >= first) { LAS float* scr = (LAS float*)(F.lds + RING_OFF + F.wave * 16384); const int lw = ((int)blockIdx.x - first) * NWAVES + F.wave, nlw = (F.G - first) * NWAVES;
            const float* wsrc = INP(25); TR_RUN(tr_plain(wsrc, DM, WSP(bf16_t, WS_WDN), DFF, r, WDN_KB_P0A), lw, nlw, 128 * (DFF / 64 - WDN_KB_P0A), scr); }
        if (BOTH(9)) GRID_BAR();
    }
    if (IN(10)) {
        pg8::Gemm g{WSP(bf16_t, WS_H), WSP(bf16_t, WS_WDN), S_, DM, DFF, DFF, DFF};
        pg8::EpiStore E{WSP(bf16_t, WS_F), DM};
        run_gemm<pg8::EpiStore, true>(F, g, E);
        if (BOTH(10)) GRID_BAR();
    }
    if (IN(11)) { p10_final(F); }
#undef IN
#undef BOTH
}

extern "C" void kernel_launch(void* const* d_in, const int* in_sizes, int n_in, void* d_out, int out_size, void* d_ws, size_t ws_size, hipStream_t stream) {
    static int grid = 0;
    if (grid == 0) {
        if (n_in != 27 || in_sizes[0] != S_ * DM || out_size != S_ * DM || ws_size < WS_END) {
            fprintf(stderr, "kernel_launch: unexpected shapes: n_in %d in0 %d out %d ws %zu (need >= %zu)\n", n_in, n_in > 0 ? in_sizes[0] : -1, out_size, ws_size, (size_t)WS_END); grid = -1; return; }
        int dev = 0, cus = 0, per_cu = 0;
        if (hipGetDevice(&dev) != hipSuccess || hipDeviceGetAttribute(&cus, hipDeviceAttributeMultiprocessorCount, dev) != hipSuccess) { grid = -1; return; }
        if (hipFuncSetAttribute((const void*)mk_fwd, hipFuncAttributeMaxDynamicSharedMemorySize, LDS_BYTES) != hipSuccess) { fprintf(stderr, "kernel_launch: hipFuncSetAttribute failed\n"); grid = -1; return; }
        if (hipOccupancyMaxActiveBlocksPerMultiprocessor(&per_cu, (const void*)mk_fwd, NWAVES * 64, LDS_BYTES) != hipSuccess || per_cu < 1)
            fprintf(stderr, "kernel_launch: note: occupancy query reports %d workgroups per CU\n", per_cu);
        (void)hipGetLastError();
        grid = cus;
    }
    if (grid < 0) return;
    (void)hipMemsetAsync((char*)d_ws + WS_CTL, 0, CTL_ZERO_BYTES, stream);
    (void)hipMemsetAsync((char*)d_ws + WS_WIN + (size_t)NIN * DM * 2, 0, (size_t)(NINP - NIN) * DM * 2, stream);
    Args a{};
    for (int i = 0; i < 27; ++i) a.in[i] = (const float*)d_in[i];
    a.out = (float*)d_out; a.ws = (unsigned char*)d_ws;
    static const int launch_list[][2] = { LAUNCH_LIST };
    constexpr int n_launch = (int)(sizeof(launch_list) / sizeof(launch_list[0]));
    static_assert(n_launch <= 32 && (CW_BAR + 32 * 4096) * 4 <= (int)CTL_ZERO_BYTES, "barrier regions");
    for (int li = 0; li < n_launch; ++li) {
        a.ph_lo = launch_list[li][0]; a.ph_hi = launch_list[li][1]; a.li = li; a.pad = 0;
        hipLaunchKernelGGL(mk_fwd, dim3(grid), dim3(NWAVES * 64), LDS_BYTES, stream, a);
        const hipError_t le = hipPeekAtLastError();
        if (le != hipSuccess) { fprintf(stderr, "kernel_launch: launch %d failed: %s\n", li, hipGetErrorName(le)); break; }
    }
}
```

```cpp
#include <hip/hip_runtime.h>
#include <cstdio>
#include <cstdint>

#ifndef LAUNCH_LIST
#define LAUNCH_LIST {0, 12}
#endif

#define LAS __attribute__((address_space(3)))
#define GAS __attribute__((address_space(1)))
typedef unsigned short bf16_t;
typedef short bf16x8 __attribute__((ext_vector_type(8)));
typedef float f32x4 __attribute__((ext_vector_type(4)));
typedef float f32x2 __attribute__((ext_vector_type(2)));
typedef float f32x16 __attribute__((ext_vector_type(16)));
typedef unsigned u32x4 __attribute__((ext_vector_type(4)));
typedef unsigned u32x2 __attribute__((ext_vector_type(2)));
typedef short s16x4 __attribute__((ext_vector_type(4)));

constexpr int S_ = 8192, DM = 4096, NIN = 5696, NINP = 5888, LRUW = 2048, QL = 1024, KVL = 512, ROPE = 64;
constexpr int NH = 16, NOPE = 128, VD = 128, DFF = 11008, NGU = 2 * DFF, NMOD = 6 * DM;
constexpr int COL_GR = 2048, COL_QL = 4096, COL_KVL = 5120, COL_KR = 5632;
constexpr float EPS = 1e-6f;
constexpr float QSCALE = 0.07216878364870322f * 1.4426950408889634f;

__device__ __forceinline__ unsigned cvt_pk_bf16(float lo, float hi) { unsigned r; asm volatile("v_cvt_pk_bf16_f32 %0, %1, %2" : "=v"(r) : "v"(lo), "v"(hi)); return r; }
__device__ __forceinline__ float bflo(unsigned w) { return __uint_as_float(w << 16); }
__device__ __forceinline__ float bfhi(unsigned w) { return __uint_as_float(w & 0xffff0000u); }
__device__ __forceinline__ float bf1(bf16_t b) { return __uint_as_float((unsigned)b << 16); }
__device__ __forceinline__ float wave_sum(float v) {
#pragma unroll
    for (int o = 1; o < 64; o <<= 1) v += __shfl_xor(v, o);
    return v;
}
__device__ __forceinline__ float sigmoidf_(float z) { return 1.0f / (1.0f + __expf(-z)); }
__device__ __forceinline__ float gelu_tanh(float x) { const float z = 0.7978845608028654f * (x + 0.044715f * x * x * x); const float t = 1.0f - 2.0f / (1.0f + __expf(2.0f * z)); return 0.5f * x * (1.0f + t); }

__device__ __forceinline__ void glds16(const void* sbase, unsigned voff, unsigned lds_dst) {
    unsigned keep;
    asm volatile("s_mov_b32 %0, m0\n\ts_mov_b32 m0, %3\n\ts_nop 0\n\tglobal_load_lds_dwordx4 %1, %2\n\ts_mov_b32 m0, %0" : "=&s"(keep) : "v"(voff), "s"(sbase), "s"(lds_dst) : "memory");
}
namespace pg8 {
constexpr int BM = 256, BK = 64, HALF = 128, HTB = HALF * BK * 2, STAGE_BYTES = 8 * HTB, NXCD = 8, WGM = 8;
__host__ __device__ __forceinline__ int lds_byte(int r, int c) { const int st = (r >> 4) * 2 + (c >> 5), rr = r & 15, cc = c & 31, ob = rr * 64 + cc * 2; return st * 1024 + (ob ^ (((ob >> 9) & 1) << 5)); }
__host__ __device__ __forceinline__ void stage_rc(int b, int& R, int& C) { const int st = b / 1024, sb = b % 1024, swz = sb ^ (((sb >> 9) & 1) << 5); R = (st >> 1) * 16 + swz / 64; C = (st & 1) * 32 + (swz % 64) / 2; }
__host__ __device__ __forceinline__ int perm32(int rho) { const int n = rho >> 4, i = rho & 15; return 8 * (i >> 2) + 4 * n + (i & 3); }
struct Unit { int pm, pn; };
struct Gemm { const bf16_t* A; const bf16_t* Bt; int M, N, K, lda, ldb; };
struct StaticOrder {
    int nM, nN, nwg, G, c;
    __host__ __device__ void init(int M, int N, int G_, int c_) { nM = M / BM; nN = N / BM; nwg = nM * nN; G = G_; c = c_; }
    __host__ __device__ bool next(int i, Unit& u) const {
        const long L = (long)i * G + c; if (L >= nwg) return false;
        int wgid = (int)L; { const int q = nwg / NXCD, r = nwg % NXCD, xcd = wgid % NXCD, off = wgid / NXCD; wgid = (xcd < r ? xcd * (q + 1) : r * (q + 1) + (xcd - r) * q) + off; }
        const int nig = WGM * nN, gid = wgid / nig, fm = gid * WGM, gsz = (nM - fm) < WGM ? (nM - fm) : WGM;
        u.pm = fm + ((wgid % nig) % gsz); u.pn = (wgid % nig) / gsz; return true;
    }
    __device__ __forceinline__ void a_ready(const Unit&) const {}
    __device__ __forceinline__ void done(const Unit&) const {}
};

template <class Epi, class Sched, bool ALIGN_EPI>
__device__ __forceinline__ void gemm_phase(LAS unsigned char* lds, const Gemm g, const Sched& S, const Epi& E) {
    const int tid = threadIdx.x, wid = __builtin_amdgcn_readfirstlane(tid >> 6), lane = tid & 63, wr = wid >> 2, wc = wid & 3, fr = lane & 15, fq = lane >> 4;
    const int K = g.K, nt = K / BK;
    unsigned voffA[2], voffB[2];
#pragma unroll
    for (int i = 0; i < 2; ++i) { int R, C; stage_rc(tid * 16 + i * 8192, R, C); const int Rb = (R & ~31) + perm32(R & 31);
        voffA[i] = (unsigned)(R * g.lda + C) * 2u; voffB[i] = (unsigned)(Rb * g.ldb + C) * 2u; }
    const size_t kstep = (size_t)(BK * 2);
    const size_t hstepA = (size_t)HALF * g.lda * 2, hstepB = (size_t)HALF * g.ldb * 2;
    const size_t tstepA = 2 * hstepA, tstepB = 2 * hstepB;
    const unsigned ldsw = (unsigned)wid * 1024u;
    const int aoff = lds_byte(wr * 64 + fr, fq * 8), boff = lds_byte(wc * 32 + fr, fq * 8);
#define PG8_SA(b, h) (((b) * 2 + (h)) * HTB)
#define PG8_SB(b, h) ((4 + (b) * 2 + (h)) * HTB)
#define PG8_STAGE(bufoff, gbase, voff) do { _Pragma("unroll") for (int _i = 0; _i < 2; ++_i) \
        __builtin_amdgcn_global_load_lds((const unsigned*)((const char*)(gbase) + (voff)[_i]), (LAS unsigned*)(lds + (bufoff) + ldsw + _i * 8192), 16, 0, 0); } while (0)
#define PG8_LDA(dst, b, h) do { _Pragma("unroll") for (int m = 0; m < 4; ++m) _Pragma("unroll") for (int k = 0; k < 2; ++k) dst[m][k] = *(const LAS bf16x8*)(lds + PG8_SA(b, h) + aoff + m * 2048 + k * 1024); } while (0)
#define PG8_LDB(dst, b, h) do { _Pragma("unroll") for (int n = 0; n < 2; ++n) _Pragma("unroll") for (int k = 0; k < 2; ++k) dst[n][k] = *(const LAS bf16x8*)(lds + PG8_SB(b, h) + boff + n * 2048 + k * 1024); } while (0)
#define PG8_MMA(ai, bj, At, Bt) do { __builtin_amdgcn_s_setprio(1); _Pragma("unroll") for (int m = 0; m < 4; ++m) _Pragma("unroll") for (int n = 0; n < 2; ++n) _Pragma("unroll") for (int k = 0; k < 2; ++k) \
        acc[ai][bj][m][n] = __builtin_amdgcn_mfma_f32_16x16x32_bf16(Bt[n][k], At[m][k], acc[ai][bj][m][n], 0, 0, 0); __builtin_amdgcn_s_setprio(0); } while (0)
#define PG8_WAIT_V(n) asm volatile("s_waitcnt vmcnt(" #n ")" ::: "memory")
#define PG8_WAIT_L(n) asm volatile("s_waitcnt lgkmcnt(" #n ")" ::: "memory")
#define PG8_BAR __builtin_amdgcn_s_barrier()
#define PG8_SCHED __builtin_amdgcn_sched_barrier(0)
    Unit cur, nxt; int ui = 0;
    if (!S.next(0, cur)) return;
    f32x4 acc[2][2][4][2];
#pragma unroll
    for (int a = 0; a < 2; ++a)
#pragma unroll
        for (int b = 0; b < 2; ++b)
#pragma unroll
            for (int m = 0; m < 4; ++m)
#pragma unroll
                for (int n = 0; n < 2; ++n) acc[a][b][m][n] = (f32x4){0.f, 0.f, 0.f, 0.f};
    bf16x8 At[4][2], B0[2][2], B1[2][2];
    const char* cA = (const char*)g.A + (size_t)cur.pm * tstepA; const char* cB = (const char*)g.Bt + (size_t)cur.pn * tstepB;
    S.a_ready(cur);
    PG8_STAGE(PG8_SB(0, 0), cB, voffB); PG8_STAGE(PG8_SB(0, 1), cB + hstepB, voffB); PG8_STAGE(PG8_SA(0, 0), cA, voffA); PG8_STAGE(PG8_SA(0, 1), cA + hstepA, voffA);
    if (wr == 1) PG8_BAR;
    PG8_WAIT_V(2); PG8_BAR;
    PG8_STAGE(PG8_SB(1, 0), cB + kstep, voffB); PG8_STAGE(PG8_SA(1, 0), cA + kstep, voffA); PG8_STAGE(PG8_SB(1, 1), cB + hstepB + kstep, voffB);
    PG8_WAIT_V(6); PG8_BAR;
    for (;;) {
        const bool has_next = S.next(ui + 1, nxt);
        const char* nA = has_next ? (const char*)g.A + (size_t)nxt.pm * tstepA : cA; const char* nB = has_next ? (const char*)g.Bt + (size_t)nxt.pn * tstepB : cB;
        for (int t = 0; t < nt; t += 2) {
            const bool last = (t == nt - 2);
            const char* a1 = cA + (size_t)(t + 1) * kstep;
            const char* a2 = last ? nA : cA + (size_t)(t + 2) * kstep; const char* b2 = last ? nB : cB + (size_t)(t + 2) * kstep;
            const char* a3 = a2 + kstep; const char* b3 = b2 + kstep;
            if (last && has_next) S.a_ready(nxt);
            PG8_LDB(B0, 0, 0); PG8_LDB(B1, 0, 1); PG8_SCHED; PG8_LDA(At, 0, 0); PG8_STAGE(PG8_SA(1, 1), a1 + hstepA, voffA);
            PG8_WAIT_V(8); PG8_WAIT_L(0); PG8_BAR; PG8_MMA(0, 0, At, B0); PG8_MMA(0, 1, At, B1); PG8_BAR; PG8_SCHED;
            PG8_LDA(At, 0, 1); PG8_STAGE(PG8_SB(0, 0), b2, voffB); PG8_STAGE(PG8_SB(0, 1), b2 + hstepB, voffB); PG8_STAGE(PG8_SA(0, 0), a2, voffA);
            PG8_WAIT_V(8); PG8_WAIT_L(0); PG8_BAR; PG8_MMA(1, 0, At, B0); PG8_MMA(1, 1, At, B1); PG8_BAR; PG8_SCHED;
            PG8_LDB(B0, 1, 0); PG8_LDB(B1, 1, 1); PG8_SCHED; PG8_LDA(At, 1, 0); PG8_STAGE(PG8_SA(0, 1), a2 + hstepA, voffA);
            PG8_WAIT_V(8); PG8_WAIT_L(0); PG8_BAR; PG8_MMA(0, 0, At, B0); PG8_MMA(0, 1, At, B1); PG8_BAR; PG8_SCHED;
            PG8_LDA(At, 1, 1); PG8_STAGE(PG8_SB(1, 0), b3, voffB); PG8_STAGE(PG8_SB(1, 1), b3 + hstepB, voffB); PG8_STAGE(PG8_SA(1, 0), a3, voffA);
            PG8_WAIT_V(8); PG8_WAIT_L(0); PG8_BAR; PG8_MMA(1, 0, At, B0); PG8_MMA(1, 1, At, B1); PG8_BAR; PG8_SCHED;
        }
        if constexpr (ALIGN_EPI) { if (wr == 0) PG8_BAR; }
        E(acc, cur, wr, wc, fr, fq); S.done(cur);
        if (!has_next) break;
#pragma unroll
        for (int a = 0; a < 2; ++a)
#pragma unroll
            for (int b = 0; b < 2; ++b)
#pragma unroll
                for (int m = 0; m < 4; ++m)
#pragma unroll
                    for (int n = 0; n < 2; ++n) acc[a][b][m][n] = (f32x4){0.f, 0.f, 0.f, 0.f};
        cur = nxt; cA = nA; cB = nB; ++ui;
        if constexpr (ALIGN_EPI) { if (wr == 1) PG8_BAR; }
    }
    PG8_WAIT_V(0);
    if constexpr (!ALIGN_EPI) { if (wr == 0) PG8_BAR; }
    PG8_BAR;
#undef PG8_SA
#undef PG8_SB
#undef PG8_STAGE
#undef PG8_LDA
#undef PG8_LDB
#undef PG8_MMA
#undef PG8_WAIT_V
#undef PG8_WAIT_L
#undef PG8_BAR
#undef PG8_SCHED
}

struct EpiStore {
    bf16_t* O; int ldc;
    __device__ __forceinline__ void operator()(const f32x4 (&acc)[2][2][4][2], const Unit& u, int wr, int wc, int fr, int fq) const {
        const int row0 = u.pm * BM + wr * 64 + fr, col0 = u.pn * BM + wc * 32 + 8 * fq;
#pragma unroll
        for (int ai = 0; ai < 2; ++ai)
#pragma unroll
            for (int m = 0; m < 4; ++m) { bf16_t* rowp = O + (size_t)(row0 + ai * HALF + m * 16) * ldc + col0;
#pragma unroll
                for (int bj = 0; bj < 2; ++bj) { const f32x4 v0 = acc[ai][bj][m][0], v1 = acc[ai][bj][m][1];
                    u32x4 w; w.x = cvt_pk_bf16(v0[0], v0[1]); w.y = cvt_pk_bf16(v0[2], v0[3]); w.z = cvt_pk_bf16(v1[0], v1[1]); w.w = cvt_pk_bf16(v1[2], v1[3]);
                    *(u32x4*)(rowp + bj * HALF) = w; } }
    }
};
struct EpiKV {
    bf16_t* KT; bf16_t* VT; const float* rs;
    __device__ __forceinline__ void operator()(const f32x4 (&acc)[2][2][4][2], const Unit& u, int wr, int wc, int fr, int fq) const {
        const int row0 = u.pm * BM + wr * 64 + fr;
#pragma unroll
        for (int ai = 0; ai < 2; ++ai)
#pragma unroll
            for (int m = 0; m < 4; ++m) { const int row = row0 + ai * HALF + m * 16; const float s = rs[row];
                const int tile = row >> 6, k = row & 63; const size_t tb = ((size_t)u.pn * 128 + tile) * 8192;
                { const f32x4 v0 = acc[ai][0][m][0] * s, v1 = acc[ai][0][m][1] * s;
                  u32x4 w; w.x = cvt_pk_bf16(v0[0], v0[1]); w.y = cvt_pk_bf16(v0[2], v0[3]); w.z = cvt_pk_bf16(v1[0], v1[1]); w.w = cvt_pk_bf16(v1[2], v1[3]);
                  *(u32x4*)(KT + tb + (4 * wc + fq) * 512 + k * 8) = w; }
                { const f32x4 v0 = acc[ai][1][m][0] * s, v1 = acc[ai][1][m][1] * s;
                  u32x4 w; w.x = cvt_pk_bf16(v0[0], v0[1]); w.y = cvt_pk_bf16(v0[2], v0[3]); w.z = cvt_pk_bf16(v1[0], v1[1]); w.w = cvt_pk_bf16(v1[2], v1[3]);
                  const int kk = (k & ~0xC) | ((k & 4) << 1) | ((k & 8) >> 1), c0 = 32 * wc + 8 * fq;
                  *(u32x4*)(VT + tb + ((kk >> 3) * 4 + (c0 >> 5)) * 256 + (kk & 7) * 32 + (c0 & 31)) = w; } }
    }
};
struct EpiQ {
    bf16_t* QN; bf16_t* QPE; const float* rs; const f32x2* cs;
    __device__ __forceinline__ void operator()(const f32x4 (&acc)[2][2][4][2], const Unit& u, int wr, int wc, int fr, int fq) const {
        const int row0 = u.pm * BM + wr * 64 + fr;
        if (u.pn < 8) {
            const int col0 = u.pn * BM + wc * 32 + 8 * fq;
#pragma unroll
            for (int ai = 0; ai < 2; ++ai)
#pragma unroll
                for (int m = 0; m < 4; ++m) { const int row = row0 + ai * HALF + m * 16; const float s = rs[row] * QSCALE; bf16_t* rowp = QN + (size_t)row * 2048 + col0;
#pragma unroll
                    for (int bj = 0; bj < 2; ++bj) { const f32x4 v0 = acc[ai][bj][m][0] * s, v1 = acc[ai][bj][m][1] * s;
                        u32x4 w; w.x = cvt_pk_bf16(v0[0], v0[1]); w.y = cvt_pk_bf16(v0[2], v0[3]); w.z = cvt_pk_bf16(v1[0], v1[1]); w.w = cvt_pk_bf16(v1[2], v1[3]);
                        *(u32x4*)(rowp + bj * HALF) = w; } }
        } else {
            const int head = 4 * (u.pn - 8) + wc, j0 = 8 * fq;
#pragma unroll
            for (int ai = 0; ai < 2; ++ai)
#pragma unroll
                for (int m = 0; m < 4; ++m) { const int row = row0 + ai * HALF + m * 16; const float s = rs[row] * QSCALE;
                    const f32x4* cp = (const f32x4*)(cs + (size_t)row * 32 + j0);
                    float o1[8], o2[8];
#pragma unroll
                    for (int q = 0; q < 4; ++q) { const f32x4 c2 = cp[q];
                        const int n = q >> 1, e = (q & 1) * 2;
                        const float x1a = acc[ai][0][m][n][e] * s, x2a = acc[ai][1][m][n][e] * s, x1b = acc[ai][0][m][n][e + 1] * s, x2b = acc[ai][1][m][n][e + 1] * s;
                        o1[2 * q] = x1a * c2[0] - x2a * c2[1]; o2[2 * q] = x2a * c2[0] + x1a * c2[1];
                        o1[2 * q + 1] = x1b * c2[2] - x2b * c2[3]; o2[2 * q + 1] = x2b * c2[2] + x1b * c2[3]; }
                    bf16_t* rowp = QPE + (size_t)row * 1024 + head * 64 + j0;
                    u32x4 w1, w2; w1.x = cvt_pk_bf16(o1[0], o1[1]); w1.y = cvt_pk_bf16(o1[2], o1[3]); w1.z = cvt_pk_bf16(o1[4], o1[5]); w1.w = cvt_pk_bf16(o1[6], o1[7]);
                    w2.x = cvt_pk_bf16(o2[0], o2[1]); w2.y = cvt_pk_bf16(o2[2], o2[3]); w2.z = cvt_pk_bf16(o2[4], o2[5]); w2.w = cvt_pk_bf16(o2[6], o2[7]);
                    *(u32x4*)rowp = w1; *(u32x4*)(rowp + 32) = w2; }
        }
    }
};
struct EpiGU {
    bf16_t* H;
    __device__ __forceinline__ void operator()(const f32x4 (&acc)[2][2][4][2], const Unit& u, int wr, int wc, int fr, int fq) const {
        const int row0 = u.pm * BM + wr * 64 + fr, col0 = u.pn * HALF + wc * 32 + 8 * fq;
#pragma unroll
        for (int ai = 0; ai < 2; ++ai)
#pragma unroll
            for (int m = 0; m < 4; ++m) { bf16_t* rowp = H + (size_t)(row0 + ai * HALF + m * 16) * DFF + col0;
                float h[8];
#pragma unroll
                for (int n = 0; n < 2; ++n)
#pragma unroll
                    for (int e = 0; e < 4; ++e) { const float gv = acc[ai][0][m][n][e], uv = acc[ai][1][m][n][e]; h[4 * n + e] = gv * __builtin_amdgcn_rcpf(1.0f + __expf(-gv)) * uv; }
                u32x4 w; w.x = cvt_pk_bf16(h[0], h[1]); w.y = cvt_pk_bf16(h[2], h[3]); w.z = cvt_pk_bf16(h[4], h[5]); w.w = cvt_pk_bf16(h[6], h[7]);
                *(u32x4*)rowp = w; }
    }
};
}

constexpr size_t MiB = 1u << 20;
constexpr size_t WS_CTL = 0, CTL_ZERO_BYTES = 1 * MiB;
constexpr size_t WS_MODP = 1 * MiB;
constexpr size_t WS_MOD = 3 * MiB;
constexpr size_t WS_CS = 4 * MiB;
constexpr size_t WS_RSQ = 6 * MiB;
constexpr size_t WS_RSKV = 6 * MiB + 65536;
constexpr size_t WS_RS1 = 6 * MiB + 131072;
constexpr size_t WS_CA = 7 * MiB;
constexpr size_t WS_CH = 7 * MiB + 512 * 1024;
constexpr size_t WS_WIN = 8 * MiB;
constexpr size_t WS_WQ = 54 * MiB;
constexpr size_t WS_WKV = 60 * MiB;
constexpr size_t WS_WG = 64 * MiB;
constexpr size_t WS_WOUT = 66 * MiB;
constexpr size_t WS_WGU = 98 * MiB;
constexpr size_t WS_WDN = 270 * MiB;
constexpr size_t WS_XN = 356 * MiB;
constexpr size_t WS_PROJ = 420 * MiB;
constexpr size_t WS_XC = 512 * MiB;
constexpr size_t WS_QN = 544 * MiB;
constexpr size_t WS_QPE = 576 * MiB;
constexpr size_t WS_KT = 592 * MiB;
constexpr size_t WS_VT = 624 * MiB;
constexpr size_t WS_KPE = 656 * MiB;
constexpr size_t WS_HLOC = 658 * MiB;
constexpr size_t WS_PP = 690 * MiB;
constexpr size_t WS_Y = 722 * MiB;
constexpr size_t WS_X1B = 722 * MiB;
constexpr size_t WS_YO = 786 * MiB;
constexpr size_t WS_H = 850 * MiB;
constexpr size_t WS_F = 1022 * MiB;
constexpr size_t WS_END = 1086 * MiB;
constexpr int CW_BAR = 4096;

constexpr int RING_OFF = 0, RING_BYTES = 131072;
constexpr int FILL_OFF = 131072;
constexpr int LDS_BYTES = 163840;
constexpr int LDSCTL_OFF = 135168;
constexpr int NWAVES = 8;

#define LDS_WAIT() asm volatile("s_waitcnt lgkmcnt(0)" ::: "memory")
#define VM_WAIT() asm volatile("s_waitcnt vmcnt(0)" ::: "memory")

#define XB_TMO      128
#define XB_XCNT(j)  (256  + 64 * (j))
#define XB_XSUB(j)  (1280 + 64 * (j))
#define XB_XGEN(j)  (2304 + 64 * (j))
#define XB_TOP      3328
#define XB_TOPGEN   3392
#define XCD_BAR_WORDS 3456
#define XB_SPIN_CAP (1u << 18)
__device__ __forceinline__ unsigned xb_ld(unsigned* p)              { return __hip_atomic_load(p, __ATOMIC_RELAXED, __HIP_MEMORY_SCOPE_AGENT); }
__device__ __forceinline__ unsigned xb_add(unsigned* p, unsigned v) { return __hip_atomic_fetch_add(p, v, __ATOMIC_RELAXED, __HIP_MEMORY_SCOPE_AGENT); }
__device__ __forceinline__ unsigned xb_xcc_id() { return (unsigned)__builtin_amdgcn_s_getreg((3 << 11) | 20) & 0xFu; }
#define XB_SPIN(cond, bar) do { unsigned _sp = 0; while (cond) { __builtin_amdgcn_s_sleep(1); \
    if ((++_sp & 255u) == 0u) { if (xb_ld(&(bar)[XB_TMO])) break; if (_sp > XB_SPIN_CAP) { atomicAdd(&(bar)[XB_TMO], 1u); break; } } } } while (0)
struct XcdBarrier { unsigned* bar; unsigned x; unsigned* st; };
__device__ __forceinline__ XcdBarrier xcd_barrier_post(unsigned* bar, unsigned* st) {
    XcdBarrier b; b.bar = bar; b.x = xb_xcc_id(); b.st = st;
    if (threadIdx.x == 0) (void)xb_add(&bar[XB_XCNT(b.x)], 1u);
    return b;
}
__device__ __forceinline__ void xcd_barrier_complete(unsigned* bar, unsigned x, unsigned& nloc, unsigned& nx) {
    const unsigned G = gridDim.x * gridDim.y * gridDim.z;
    unsigned sum, cnt, mine, sp = 0u;
    for (;;) {
        sum = 0u; cnt = 0u; mine = 0u;
#pragma unroll
        for (unsigned j = 0; j < 16; ++j) { const unsigned c = xb_ld(&bar[XB_XCNT(j)]); sum += c; cnt += (c > 0u) ? 1u : 0u; mine = (j == x) ? c : mine; }
        if (sum == G) break;
        __builtin_amdgcn_s_sleep(1);
        if ((++sp & 255u) == 0u) { if (xb_ld(&bar[XB_TMO])) break; if (sp > XB_SPIN_CAP) { atomicAdd(&bar[XB_TMO], 1u); break; } }
    }
    nloc = mine > 0u ? mine : 1u; nx = cnt > 0u ? cnt : 1u;
}
__device__ __forceinline__ void xcd_barrier(const XcdBarrier& b) {
    asm volatile("s_waitcnt vmcnt(0)" ::: "memory");
    __syncthreads();
    if (threadIdx.x == 0) {
        unsigned* bar = b.bar;
        __builtin_amdgcn_s_waitcnt(0);
        unsigned nloc = xb_ld(&b.st[0]), nx = xb_ld(&b.st[1]);
        if (nloc == 0u) { xcd_barrier_complete(bar, b.x, nloc, nx); __hip_atomic_store(&b.st[0], nloc, __ATOMIC_RELAXED, __HIP_MEMORY_SCOPE_AGENT); __hip_atomic_store(&b.st[1], nx, __ATOMIC_RELAXED, __HIP_MEMORY_SCOPE_AGENT); }
        const unsigned old = xb_add(&bar[XB_XSUB(b.x)], 1u);
        const unsigned gen = old / nloc;
        if (old + 1u == (gen + 1u) * nloc) {
            __builtin_amdgcn_fence(__ATOMIC_RELEASE, "agent");
            asm volatile("s_waitcnt vmcnt(0)" ::: "memory");
            const unsigned og = xb_add(&bar[XB_TOP], 1u);
            const unsigned tg = og / nx;
            if (og + 1u == (tg + 1u) * nx) xb_add(&bar[XB_TOPGEN], 1u);
            else XB_SPIN(xb_ld(&bar[XB_TOPGEN]) == tg, bar);
            __builtin_amdgcn_fence(__ATOMIC_ACQUIRE, "agent");
            xb_add(&bar[XB_XGEN(b.x)], 1u);
            asm volatile("s_waitcnt vmcnt(0)" ::: "memory");
        } else {
            XB_SPIN(xb_ld(&bar[XB_XGEN(b.x)]) == gen, bar);
            __builtin_amdgcn_fence(__ATOMIC_ACQUIRE, "agent");
            asm volatile("s_waitcnt vmcnt(0)" ::: "memory");
        }
    }
    __syncthreads();
}

struct Frame {
    LAS unsigned char* lds;
    int wave, vcu, G;
    float* out;
    unsigned char* ws;
};
#define WSP(T, off) ((T*)(F.ws + (off)))
__device__ __forceinline__ int lane_id() { return (int)__builtin_amdgcn_mbcnt_hi(~0u, __builtin_amdgcn_mbcnt_lo(~0u, 0u)); }
template <int OFF> __device__ __forceinline__ const float* arg_ptr() {
    unsigned long long p; const unsigned long long k = (unsigned long long)__builtin_amdgcn_kernarg_segment_ptr();
    asm volatile("s_load_dwordx2 %0, %1, %2\n\ts_waitcnt lgkmcnt(0)" : "=s"(p) : "s"(k), "i"(OFF));
    return (const float*)p;
}
#define INP(i) arg_ptr<8 * (i)>()

constexpr int WDN_KB_P0A = 64;
constexpr int WGU_KB_P0A = 46;
struct TrIt { const float* src; bf16_t* dst; const float* ks; int ldw, K; };
__device__ __forceinline__ void tr_load(const TrIt& t, f32x4 (&v)[8], int lane) {
    const int kr = lane >> 3, c4 = lane & 7;
#pragma unroll
    for (int i = 0; i < 8; ++i) v[i] = __builtin_nontemporal_load((const GAS f32x4*)(t.src + (size_t)(kr + 8 * i) * t.ldw + 4 * c4));
}
__device__ __forceinline__ void tr_put(const TrIt& t, f32x4 (&v)[8], LAS float* scr, int lane) {
    const int kr = lane >> 3, c4 = lane & 7;
    if (t.ks) {
#pragma unroll
        for (int i = 0; i < 8; ++i) v[i] *= t.ks[kr + 8 * i];
    }
#pragma unroll
    for (int i = 0; i < 8; ++i) { LAS float* d = scr + (kr + 8 * i) * 33 + 4 * c4; d[0] = v[i][0]; d[1] = v[i][1]; d[2] = v[i][2]; d[3] = v[i][3]; }
    LDS_WAIT(); asm volatile("" ::: "memory");
    const int c = lane & 7;
#pragma unroll
    for (int j = 0; j < 4; ++j) { const int n = (lane >> 3) + 8 * j; const LAS float* s = scr + (8 * c) * 33 + n;
        u32x4 o; o.x = cvt_pk_bf16(s[0 * 33], s[1 * 33]); o.y = cvt_pk_bf16(s[2 * 33], s[3 * 33]); o.z = cvt_pk_bf16(s[4 * 33], s[5 * 33]); o.w = cvt_pk_bf16(s[6 * 33], s[7 * 33]);
        *(GAS u32x4*)(t.dst + (size_t)n * t.K + 8 * c) = o; }
    LDS_WAIT(); asm volatile("" ::: "memory");
}
__device__ __forceinline__ TrIt tr_mk(const float* W, int ldw, int c0, bf16_t* WT, int K, int n0, int k0, const float* kscale) {
    TrIt t; t.src = W + (size_t)k0 * ldw + c0; t.dst = WT + (size_t)n0 * K + k0; t.ks = kscale ? kscale + k0 : nullptr; t.ldw = ldw; t.K = K; return t; }
__device__ __forceinline__ TrIt tr_plain(const float* W, int N, bf16_t* WT, int K, int r, int kb0 = 0) { const int nnb = N / 32, nb = r % nnb, kb = kb0 + r / nnb; return tr_mk(W, N, nb * 32, WT, K, nb * 32, kb * 64, nullptr); }
#define TR_RUN(DECODE, first, stride, count, scr) do { const int ln_ = lane_id(); f32x4 va_[8], vb_[8]; TrIt cur_, nxt_; int r_ = (first); \
        if (r_ < (count)) { { const int r = r_; cur_ = (DECODE); } tr_load(cur_, va_, ln_); } \
        for (; r_ < (count); r_ += (stride)) { const bool hn_ = r_ + (stride) < (count); \
            if (hn_) { { const int r = r_ + (stride); nxt_ = (DECODE); } tr_load(nxt_, vb_, ln_); } \
            tr_put(cur_, va_, (scr), ln_); \
            if (hn_) { cur_ = nxt_; _Pragma("unroll") for (int i_ = 0; i_ < 8; ++i_) va_[i_] = vb_[i_]; } } } while (0)
__device__ __forceinline__ TrIt wgu_item(const float* wg, const float* wu, bf16_t* WT, int r, int kb0) {
    const int nb = r % 688, kb = kb0 + r / 688, t = nb >> 3, q = nb & 7;
    return tr_mk((q < 4) ? wg : wu, DFF, t * 128 + (q & 3) * 32, WT, DM, nb * 32, kb * 64, nullptr); }
__device__ __forceinline__ TrIt p0a_decode(Frame& F, int r) {
    constexpr int I_WIN = (NIN / 32) * (DM / 64), I_WQ = 96 * (QL / 64), I_WKV = 128 * (KVL / 64), I_WGU = (NGU / 32) * WGU_KB_P0A;
    if (r < I_WIN) return tr_plain(INP(6), NIN, WSP(bf16_t, WS_WIN), DM, r);
    r -= I_WIN;
    if (r < I_WQ) { const int nb = r % 96, kb = r / 96; int src;
        if (nb < 64) src = (nb >> 2) * 192 + (nb & 3) * 32; else { const int q = nb - 64, T = q >> 3, half = (q >> 2) & 1, hh = q & 3; src = (4 * T + hh) * 192 + 128 + half * 32; }
        return tr_mk(INP(15), NH * 192, src, WSP(bf16_t, WS_WQ), QL, nb * 32, kb * 64, INP(14)); }
    r -= I_WQ;
    if (r < I_WKV) { const int nb = r % 128, kb = r / 128; return tr_mk(INP(17), NH * 256, nb * 32, WSP(bf16_t, WS_WKV), KVL, nb * 32, kb * 64, INP(16)); }
    r -= I_WKV;
    if (r < I_WGU) return wgu_item(INP(23), INP(24), WSP(bf16_t, WS_WGU), r, 0);
    r -= I_WGU;
    if (r < 128 * WDN_KB_P0A) return tr_plain(INP(25), DM, WSP(bf16_t, WS_WDN), DFF, r);
    r -= 128 * WDN_KB_P0A;
    { const int kb = r & 1, jb = (r >> 1) & 3, gate = (r >> 3) & 1, n = r >> 4;
      return tr_mk((gate ? INP(11) : INP(9)) + (size_t)n * 16384, 128, jb * 32, WSP(bf16_t, WS_WG) + (size_t)(n * 256 + gate * 128) * 128, 128, jb * 32, kb * 64, nullptr); }
}
__device__ __forceinline__ void p0a_prep(Frame& F) {
    LAS float* scr = (LAS float*)(F.lds + RING_OFF + F.wave * 16384);
    const int gw = F.vcu * NWAVES + F.wave, NGW = F.G * NWAVES;
    {
        const float* cvec = INP(1); const GAS f32x4* W4 = (const GAS f32x4*)INP(3);
        LAS float* red = (LAS float*)(F.lds + FILL_OFF);
        for (int v = F.vcu; v < 192; v += F.G) {
            const int cg = v % 96, kh = v / 96, ks = kh * 8 + F.wave;
            f32x4 acc = (f32x4){0.f, 0.f, 0.f, 0.f};
            const GAS f32x4* wp = W4 + (size_t)(ks * 256) * (NMOD / 4) + cg * 64 + lane_id();
#pragma unroll 8
            for (int k = 0; k < 256; ++k) { const float cv = cvec[ks * 256 + k]; const float sv = cv / (1.0f + __expf(-cv)); acc += __builtin_nontemporal_load(wp + (size_t)k * (NMOD / 4)) * sv; }
            *(LAS f32x4*)(red + F.wave * 256 + 4 * lane_id()) = acc;
            __syncthreads();
            if (F.wave < 4) { const int col = F.wave * 64 + lane_id(); float t = 0.f;
#pragma unroll
                for (int w = 0; w < 8; ++w) t += red[w * 256 + col];
                WSP(float, WS_MODP)[(size_t)kh * NMOD + cg * 256 + col] = t; }
            __syncthreads();
        }
    }
    {
        const int* pos = (const int*)INP(2); f32x2* CS = WSP(f32x2, WS_CS);
        for (int idx = gw * 64 + lane_id(); idx < S_ * 32; idx += NGW * 64) {
            const int t = idx >> 5, j = idx & 31;
            const float inv = (float)exp(-(double)j * (9.210340371976184 / 32.0));
            const float ang = (float)pos[t] * inv;
            const double rev = (double)ang * 0.15915494309189535; const double fr = rev - rint(rev);
            const float frf = (float)fr;
            CS[idx] = (f32x2){__builtin_amdgcn_cosf(frf), __builtin_amdgcn_sinf(frf)};
        }
    }
    constexpr int NITEMS = (NIN / 32) * (DM / 64) + 96 * (QL / 64) + 128 * (KVL / 64) + (NGU / 32) * WGU_KB_P0A + 128 * WDN_KB_P0A + 16 * 2 * 4 * 2;
    TR_RUN(p0a_decode(F, r), gw, NGW, NITEMS, scr);
}

__device__ __forceinline__ float mod_col(const float* MP, const float* bmod, int col) {
    float s = bmod[col];
#pragma unroll
    for (int ks = 0; ks < 2; ++ks) s += MP[(size_t)ks * NMOD + col];
    return s;
}
__device__ __forceinline__ void p0b_xn(Frame& F) {
    const float* MP = WSP(float, WS_MODP); const float* bmod = INP(4);
    LAS float* cA = (LAS float*)(F.lds + RING_OFF); LAS float* cB = cA + DM;
    for (int ch = (F.wave * 64 + lane_id()); ch < DM; ch += NWAVES * 64) { const float sh = mod_col(MP, bmod, ch), sc = mod_col(MP, bmod, DM + ch); cA[ch] = INP(5)[ch] * (1.0f + sc); cB[ch] = sh; }
    { float* MOD = WSP(float, WS_MOD); for (int i = blockIdx.x * (NWAVES * 64) + (F.wave * 64 + lane_id()); i < NMOD; i += F.G * NWAVES * 64) MOD[i] = mod_col(MP, bmod, i); }
    __syncthreads();
    const int gw = F.vcu * NWAVES + F.wave, NGW = F.G * NWAVES;
    for (int row = gw; row < S_; row += NGW) {
        const GAS f32x4* xr = (const GAS f32x4*)(INP(0) + (size_t)row * DM) + lane_id();
        f32x4 v[16]; float s = 0.f;
#pragma unroll
        for (int j = 0; j < 16; ++j) { v[j] = __builtin_nontemporal_load(xr + 64 * j); s += (v[j][0] * v[j][0] + v[j][1] * v[j][1]) + (v[j][2] * v[j][2] + v[j][3] * v[j][3]); }
        const float rstd = 1.0f / sqrtf(wave_sum(s) * (1.0f / DM) + EPS);
        u32x2* o8 = (u32x2*)(WSP(bf16_t, WS_XN) + (size_t)row * DM) + lane_id();
#pragma unroll
        for (int j = 0; j < 16; ++j) { const f32x4 a = *(const LAS f32x4*)(cA + 4 * (lane_id() + 64 * j)), b = *(const LAS f32x4*)(cB + 4 * (lane_id() + 64 * j));
            const f32x4 h = v[j] * rstd * a + b; u32x2 w; w.x = cvt_pk_bf16(h[0], h[1]); w.y = cvt_pk_bf16(h[2], h[3]); o8[64 * j] = w; }
    }
    __syncthreads();
}

__device__ __forceinline__ void p2_thin(Frame& F) {
    const int gw = F.vcu * NWAVES + F.wave, NGW = F.G * NWAVES;
    const bf16_t* PROJ = WSP(bf16_t, WS_PROJ);
    for (int row = gw; row < S_; row += NGW) {
        const bf16_t* pr = PROJ + (size_t)row * NINP;
        { const u32x4* q = (const u32x4*)(pr + COL_QL) + 2 * lane_id(); float s = 0.f;
#pragma unroll
          for (int i = 0; i < 2; ++i) { const u32x4 w = q[i];
#pragma unroll
            for (int e = 0; e < 4; ++e) { const float a = bflo(w[e]), b = bfhi(w[e]); s += a * a + b * b; } }
          s = wave_sum(s); if (lane_id() == 0) WSP(float, WS_RSQ)[row] = 1.0f / sqrtf(s * (1.0f / QL) + EPS); }
        { const u32x4 w = ((const u32x4*)(pr + COL_KVL))[lane_id()]; float s = 0.f;
#pragma unroll
          for (int e = 0; e < 4; ++e) { const float a = bflo(w[e]), b = bfhi(w[e]); s += a * a + b * b; }
          s = wave_sum(s); if (lane_id() == 0) WSP(float, WS_RSKV)[row] = 1.0f / sqrtf(s * (1.0f / KVL) + EPS); }
        if (lane_id() < 32) { const float x1 = bf1(pr[COL_KR + lane_id()]), x2 = bf1(pr[COL_KR + 32 + lane_id()]); const f32x2 c = WSP(f32x2, WS_CS)[(size_t)row * 32 + lane_id()];
            bf16_t* kp = WSP(bf16_t, WS_KPE) + (size_t)(row >> 6) * 4096 + (row & 63) * 8; const int d = lane_id();
            kp[(d >> 3) * 512 + (d & 7)] = (bf16_t)(cvt_pk_bf16(x1 * c[0] - x2 * c[1], 0.f) & 0xffffu); kp[((32 + d) >> 3) * 512 + (d & 7)] = (bf16_t)(cvt_pk_bf16(x2 * c[0] + x1 * c[1], 0.f) & 0xffffu); }
    }
    const float* cw = INP(7); const float* cb = INP(8);
    for (int item = gw * 64 + lane_id(); item < (S_ / 16) * (LRUW / 8); item += NGW * 64) {
        const int t0 = (item >> 8) * 16, ch0 = (item & 255) * 8;
        const GAS bf16_t* xp = (const GAS bf16_t*)PROJ + (size_t)t0 * NINP + ch0;
        u32x4 xr[19];
#pragma unroll
        for (int i = 0; i < 19; ++i) xr[i] = (t0 - 3 + i >= 0) ? *(const GAS u32x4*)(xp + (ptrdiff_t)(i - 3) * NINP) : (u32x4){0u, 0u, 0u, 0u};
        f32x4 wq[4][2], bq[2];
#pragma unroll
        for (int k = 0; k < 4; ++k) { wq[k][0] = *(const f32x4*)(cw + k * LRUW + ch0); wq[k][1] = *(const f32x4*)(cw + k * LRUW + ch0 + 4); }
        bq[0] = *(const f32x4*)(cb + ch0); bq[1] = *(const f32x4*)(cb + ch0 + 4);
        GAS bf16_t* op = (GAS bf16_t*)WSP(bf16_t, WS_XC) + (size_t)t0 * LRUW + ch0;
#pragma unroll
        for (int i = 0; i < 16; ++i) { f32x4 a0 = bq[0], a1 = bq[1];
#pragma unroll
            for (int k = 0; k < 4; ++k) { const u32x4 w = xr[i + k];
                a0 += wq[k][0] * (f32x4){bflo(w[0]), bfhi(w[0]), bflo(w[1]), bfhi(w[1])}; a1 += wq[k][1] * (f32x4){bflo(w[2]), bfhi(w[2]), bflo(w[3]), bfhi(w[3])}; }
            u32x4 o; o.x = cvt_pk_bf16(a0[0], a0[1]); o.y = cvt_pk_bf16(a0[2], a0[3]); o.z = cvt_pk_bf16(a1[0], a1[1]); o.w = cvt_pk_bf16(a1[2], a1[3]);
            *(GAS u32x4*)(op + (size_t)i * LRUW) = o; }
    }
}

__device__ __forceinline__ int crow(int r, int hi) { return (r & 3) + 8 * (r >> 2) + 4 * hi; }
__device__ __forceinline__ void lru_task(Frame& F, int task) {
    const int lane = lane_id(), r32 = lane & 31, hi = lane >> 5;
    const int cg = task & 3, n = (task >> 2) & 15, chunk = task >> 6;
    const int ch = n * 128 + cg * 32 + r32;
    const bf16_t* WG = WSP(bf16_t, WS_WG) + (size_t)n * 256 * 128;
    bf16x8 Ba[8], Bx[8];
#pragma unroll
    for (int ks = 0; ks < 8; ++ks) { Ba[ks] = *(const bf16x8*)(WG + (size_t)(cg * 32 + r32) * 128 + ks * 16 + hi * 8); Bx[ks] = *(const bf16x8*)(WG + (size_t)(128 + cg * 32 + r32) * 128 + ks * 16 + hi * 8); }
    const float ba = INP(10)[ch], bx = INP(12)[ch];
    const float lam = INP(13)[ch];
    const float nsp8 = -8.0f * log1pf(__expf(-lam));
    bf16_t* HL = WSP(bf16_t, WS_HLOC); bf16_t* PPo = WSP(bf16_t, WS_PP);
    float Sst = 0.f, Qst = 1.f;
    bf16x8 E0, E1;
#pragma unroll
    for (int j = 0; j < 8; ++j) { E0[j] = (8 * hi + j == r32) ? (short)0x3F80 : (short)0; E1[j] = (16 + 8 * hi + j == r32) ? (short)0x3F80 : (short)0; }
    const GAS char* xcb = (const GAS char*)(WSP(bf16_t, WS_XC) + (size_t)chunk * 256 * LRUW + n * 128);
    const unsigned xlo = (unsigned)(r32 * LRUW + hi * 8) * 2u;
    bf16x8 A[8], An[8];
#pragma unroll
    for (int ks = 0; ks < 8; ++ks) A[ks] = *(const GAS bf16x8*)(xcb + xlo + ks * 32);
    for (int ti = 0; ti < 8; ++ti) {
        const int t0 = chunk * 256 + ti * 32;
        if (ti + 1 < 8) {
#pragma unroll
            for (int ks = 0; ks < 8; ++ks) An[ks] = *(const GAS bf16x8*)(xcb + (size_t)(ti + 1) * (32 * LRUW * 2) + xlo + ks * 32);
        }
        f32x16 aa = {}, ax = {}, xt = {};
#pragma unroll
        for (int ks = 0; ks < 8; ++ks) { aa = __builtin_amdgcn_mfma_f32_32x32x16_bf16(A[ks], Ba[ks], aa, 0, 0, 0); ax = __builtin_amdgcn_mfma_f32_32x32x16_bf16(A[ks], Bx[ks], ax, 0, 0, 0); }
        { const bf16x8 xa0 = (cg == 0) ? A[0] : (cg == 1) ? A[2] : (cg == 2) ? A[4] : A[6], xa1 = (cg == 0) ? A[1] : (cg == 1) ? A[3] : (cg == 2) ? A[5] : A[7];
          xt = __builtin_amdgcn_mfma_f32_32x32x16_bf16(xa0, E0, xt, 0, 0, 0); xt = __builtin_amdgcn_mfma_f32_32x32x16_bf16(xa1, E1, xt, 0, 0, 0); }
        float av[16], uv[16];
#pragma unroll
        for (int r = 0; r < 16; ++r) {
            const float xv = xt[r];
            const float rg = sigmoidf_(aa[r] + ba), ig = sigmoidf_(ax[r] + bx);
            const float la = nsp8 * rg, x2 = 2.0f * la;
            av[r] = __expf(la);
            const float poly = -x2 * (1.0f + x2 * (0.5f + x2 * (0.16666667f + x2 * (0.041666668f + x2 * (0.0083333338f + x2 * 0.0013888889f)))));
            const float om = (x2 > -0.25f) ? poly : (1.0f - __expf(x2));
            uv[r] = __builtin_amdgcn_sqrtf(om) * (ig * xv);
        }
        float Pg[4], Hg[4];
#pragma unroll
        for (int g = 0; g < 4; ++g) { float P = 1.f, Hh = 0.f;
#pragma unroll
            for (int i = 0; i < 4; ++i) { const int r = 4 * g + i; Hh = av[r] * Hh + uv[r]; P *= av[r]; uv[r] = Hh; av[r] = P; }
            Pg[g] = P; Hg[g] = Hh; }
#pragma unroll
        for (int g = 0; g < 4; ++g) {
            const float Po = __shfl_xor(Pg[g], 32), Ho = __shfl_xor(Hg[g], 32);
            const float P0 = hi ? Po : Pg[g], H0 = hi ? Ho : Hg[g], P1 = hi ? Pg[g] : Po, H1 = hi ? Hg[g] : Ho;
            const float S0 = Sst, Q0 = Qst; Sst = P0 * Sst + H0; Qst = Qst * P0;
            const float S1 = Sst, Q1 = Qst; Sst = P1 * Sst + H1; Qst = Qst * P1;
            const float cS = hi ? S1 : S0, cQ = hi ? Q1 : Q0;
#pragma unroll
            for (int i = 0; i < 4; ++i) { const int r = 4 * g + i; const size_t o = (size_t)(t0 + crow(r, hi)) * LRUW + ch;
                HL[o] = (bf16_t)(cvt_pk_bf16(uv[r] + av[r] * cS, 0.f) & 0xffffu); PPo[o] = (bf16_t)(cvt_pk_bf16(av[r] * cQ, 0.f) & 0xffffu); }
        }
#pragma unroll
        for (int ks = 0; ks < 8; ++ks) A[ks] = An[ks];
    }
    if (hi == 0) { WSP(float, WS_CA)[chunk * LRUW + ch] = Qst; WSP(float, WS_CH)[chunk * LRUW + ch] = Sst; }
}

#define KSLOT 24576
#define VSLOT 16384
constexpr int ATT_K0 = 0, ATT_V0 = 2 * KSLOT, ATT_WS = 2 * KSLOT + 3 * VSLOT, ATT_QPE = ATT_WS + NWAVES * 256, ATT_LDS = ATT_QPE + NWAVES * 4096;
static_assert(ATT_LDS <= LDSCTL_OFF, "attention LDS");
__device__ __forceinline__ int v_rd_base(int lane) { return ((lane & 3) << 3) | (((lane >> 2) & 3) << 6) | (((lane >> 4) & 1) << 5) | (((lane >> 5) & 1) << 8); }
constexpr int v_rd_off(int d0, int ks, int half) { return d0 * 512 + ks * 4096 + half * 2048; }
template <int OFF> __device__ __forceinline__ s16x4 tr_read(int vb) { s16x4 r; asm volatile("ds_read_b64_tr_b16 %0, %1 offset:%2" : "=&v"(r) : "v"(vb), "i"(OFF) : "memory"); return r; }
__device__ __forceinline__ void glds16s(const void* sbase, unsigned voff, unsigned lds_dst) {
    unsigned keep;
    asm volatile("s_mov_b32 %0, m0\n\ts_mov_b32 m0, %3\n\ts_nop 0\n\tglobal_load_lds_dwordx4 %1, %2\n\ts_mov_b32 m0, %0" : "=&s"(keep) : "v"(voff), "s"(sbase), "s"(lds_dst) : "memory");
}
struct VFr { s16x4 l0, h0, l1, h1, l2, h2, l3, h3; };
template <int D0> __device__ __forceinline__ void v_rd(VFr& f, int vb) {
    f.l0 = tr_read<v_rd_off(D0, 0, 0)>(vb); f.h0 = tr_read<v_rd_off(D0, 0, 1)>(vb); f.l1 = tr_read<v_rd_off(D0, 1, 0)>(vb); f.h1 = tr_read<v_rd_off(D0, 1, 1)>(vb);
    f.l2 = tr_read<v_rd_off(D0, 2, 0)>(vb); f.h2 = tr_read<v_rd_off(D0, 2, 1)>(vb); f.l3 = tr_read<v_rd_off(D0, 3, 0)>(vb); f.h3 = tr_read<v_rd_off(D0, 3, 1)>(vb);
}
__device__ __forceinline__ void v_mma(f32x16& od, const VFr& f, bf16x8 pa0, bf16x8 pa1, bf16x8 pa2, bf16x8 pa3) {
#define PK(L, H) (bf16x8){L[0], L[1], L[2], L[3], H[0], H[1], H[2], H[3]}
    od = __builtin_amdgcn_mfma_f32_32x32x16_bf16(pa0, PK(f.l0, f.h0), od, 0, 0, 0);
    od = __builtin_amdgcn_mfma_f32_32x32x16_bf16(pa1, PK(f.l1, f.h1), od, 0, 0, 0);
    od = __builtin_amdgcn_mfma_f32_32x32x16_bf16(pa2, PK(f.l2, f.h2), od, 0, 0, 0);
    od = __builtin_amdgcn_mfma_f32_32x32x16_bf16(pa3, PK(f.l3, f.h3), od, 0, 0, 0);
#undef PK
}
__device__ __forceinline__ void pv_tile(f32x16 (&o)[4], int vb, bf16x8 pa0, bf16x8 pa1, bf16x8 pa2, bf16x8 pa3) {
    VFr fa, fb;
    v_rd<0>(fa, vb); v_rd<1>(fb, vb);
    asm volatile("s_waitcnt lgkmcnt(8)" ::: "memory"); __builtin_amdgcn_sched_barrier(0);
    v_mma(o[0], fa, pa0, pa1, pa2, pa3); __builtin_amdgcn_sched_barrier(0);
    v_rd<2>(fa, vb);
    asm volatile("s_waitcnt lgkmcnt(8)" ::: "memory"); __builtin_amdgcn_sched_barrier(0);
    v_mma(o[1], fb, pa0, pa1, pa2, pa3); __builtin_amdgcn_sched_barrier(0);
    v_rd<3>(fb, vb);
    asm volatile("s_waitcnt lgkmcnt(8)" ::: "memory"); __builtin_amdgcn_sched_barrier(0);
    v_mma(o[2], fa, pa0, pa1, pa2, pa3); __builtin_amdgcn_sched_barrier(0);
    asm volatile("s_waitcnt lgkmcnt(0)" ::: "memory"); __builtin_amdgcn_sched_barrier(0);
    v_mma(o[3], fb, pa0, pa1, pa2, pa3); __builtin_amdgcn_sched_barrier(0);
}
__device__ __forceinline__ void attn_unit(Frame& F, int h, int qb) {
    const int lane = lane_id(), wid = F.wave, r32 = lane & 31, hi = lane >> 5;
    const bool lag = wid >= 4;
    const bf16_t* QN = WSP(bf16_t, WS_QN); const bf16_t* QPE = WSP(bf16_t, WS_QPE);
    LAS unsigned char* lds = F.lds + RING_OFF;
    LAS float* wsf = (LAS float*)(lds + ATT_WS) + wid * 64;
    const int q0 = qb * 256 + wid * 32;
    const int NT = 4 * qb + 4, my_nt = 4 * qb + (wid >> 1) + 1;
    const char* ktb0 = (const char*)WSP(bf16_t, WS_KT) + (size_t)h * (128 * 16384) + wid * 1024;
    const char* vtb0 = (const char*)WSP(bf16_t, WS_VT) + (size_t)h * (128 * 16384) + wid * 1024;
    const char* kpb0 = (const char*)WSP(bf16_t, WS_KPE) + wid * 1024;
    const unsigned lo16 = (unsigned)lane * 16u;
    const unsigned ldsK = (unsigned)(uintptr_t)(lds + ATT_K0), ldsV = (unsigned)(uintptr_t)(lds + ATT_V0);
#define ATT_DMA1(p, tile, kslot, vslot) do { \
        if ((p) == 0) glds16s(ktb0 + (size_t)(tile) * 16384, lo16, ldsK + (kslot) * KSLOT + wid * 1024); \
        if ((p) == 1) glds16s(ktb0 + (size_t)(tile) * 16384 + 8192, lo16, ldsK + (kslot) * KSLOT + wid * 1024 + 8192); \
        if ((p) == 2) glds16s(kpb0 + (size_t)(tile) * 8192, lo16, ldsK + (kslot) * KSLOT + wid * 1024 + 16384); \
        if ((p) == 3) glds16s(vtb0 + (size_t)(tile) * 16384, lo16, ldsV + (vslot) * VSLOT + wid * 1024); \
        if ((p) == 4) glds16s(vtb0 + (size_t)(tile) * 16384 + 8192, lo16, ldsV + (vslot) * VSLOT + wid * 1024 + 8192); } while (0)
#define ATT_DMA(tile, kslot, vslot) do { ATT_DMA1(0, tile, kslot, vslot); ATT_DMA1(1, tile, kslot, vslot); ATT_DMA1(2, tile, kslot, vslot); ATT_DMA1(3, tile, kslot, vslot); ATT_DMA1(4, tile, kslot, vslot); } while (0)
    asm volatile("s_waitcnt lgkmcnt(0)" ::: "memory"); __builtin_amdgcn_s_barrier(); asm volatile("" ::: "memory");
    ATT_DMA(0, 0, 0);
    bf16x8 qr[8];
#pragma unroll
    for (int d0 = 0; d0 < 8; ++d0) qr[d0] = *(const bf16x8*)(QN + (size_t)(q0 + r32) * 2048 + h * 128 + d0 * 16 + hi * 8);
    LAS unsigned char* qpl = lds + ATT_QPE + wid * 4096 + lane * 16;
#pragma unroll
    for (int d0 = 0; d0 < 4; ++d0) *(LAS bf16x8*)(qpl + d0 * 1024) = *(const bf16x8*)(QPE + (size_t)(q0 + r32) * 1024 + h * 64 + d0 * 16 + hi * 8);
    f32x16 o[4] = {}; float m_reg = -1e30f, l_reg = 0.f;
    bf16x8 pa0 = {}, pa1 = {}, pa2 = {}, pa3 = {};
    const int vbase = (int)(uintptr_t)(lds + ATT_V0) + v_rd_base(lane);
    int vs_cur = 0, vs_prev = 0;
    for (int j = 0; j < NT; ++j) {
        asm volatile("s_waitcnt vmcnt(0)" ::: "memory"); __builtin_amdgcn_s_barrier(); asm volatile("" ::: "memory");
        const int vs_next = (vs_cur == 2 * VSLOT) ? 0 : vs_cur + VSLOT;
        const int vsl = (vs_next == 0) ? 0 : (vs_next == VSLOT ? 1 : 2); const bool pre = (j + 1 < NT);
        if (pre && j >= my_nt) ATT_DMA(j + 1, (j + 1) & 1, vsl);
        if (lag && j >= 1 && j - 1 < my_nt) pv_tile(o, vbase + vs_prev, pa0, pa1, pa2, pa3);
        if (j < my_nt) {
            f32x16 p0 = {}, p1 = {};
            const LAS unsigned char* kb = lds + ATT_K0 + (j & 1) * KSLOT + hi * 1024 + r32 * 16;
            bf16x8 kf[4][2], qpf[4];
#define KLD(s) do { kf[(s) & 3][0] = *(const LAS bf16x8*)(kb + (s) * 2048); kf[(s) & 3][1] = *(const LAS bf16x8*)(kb + (s) * 2048 + 512); } while (0)
            __builtin_amdgcn_sched_barrier(0);
            KLD(0); KLD(1); KLD(2); KLD(3);
            __builtin_amdgcn_sched_barrier(0);
#pragma unroll
            for (int s = 0; s < 12; ++s) {
                if (s == 4) {
#pragma unroll
                    for (int d = 0; d < 4; ++d) qpf[d] = *(const LAS bf16x8*)(qpl + d * 1024);
                }
                const bf16x8 qf = (s < 8) ? qr[s & 7] : qpf[s & 3];
                p0 = __builtin_amdgcn_mfma_f32_32x32x16_bf16(kf[s & 3][0], qf, p0, 0, 0, 0); p1 = __builtin_amdgcn_mfma_f32_32x32x16_bf16(kf[s & 3][1], qf, p1, 0, 0, 0);
                __builtin_amdgcn_sched_barrier(0);
                if (s + 4 < 12) KLD(s + 4);
                if (pre && (s & 1) == 1 && s < 10) ATT_DMA1(s >> 1, j + 1, (j + 1) & 1, vsl);
                __builtin_amdgcn_sched_barrier(0);
            }
#undef KLD
            float mx = fmaxf(p0[0], p1[0]);
#pragma unroll
            for (int r = 1; r < 16; ++r) mx = fmaxf(fmaxf(mx, p0[r]), p1[r]);
            { auto rr = __builtin_amdgcn_permlane32_swap(__float_as_uint(mx), __float_as_uint(mx), false, false); mx = fmaxf(__uint_as_float(rr[0]), __uint_as_float(rr[1])); }
            if (__any(mx - m_reg > 8.0f)) {
                const float mn = fmaxf(m_reg, mx); const float alpha = __builtin_amdgcn_exp2f(m_reg - mn); m_reg = mn; l_reg *= alpha;
                if (hi == 0) wsf[r32] = alpha; asm volatile("s_waitcnt lgkmcnt(0)" ::: "memory");
#pragma unroll
                for (int d = 0; d < 4; ++d)
#pragma unroll
                    for (int r = 0; r < 16; ++r) o[d][r] *= wsf[crow(r, hi)];
            }
            float ps = 0.f;
#pragma unroll
            for (int r = 0; r < 16; ++r) { p0[r] = __builtin_amdgcn_exp2f(p0[r] - m_reg); p1[r] = __builtin_amdgcn_exp2f(p1[r] - m_reg); ps += p0[r] + p1[r]; }
            { auto rr = __builtin_amdgcn_permlane32_swap(__float_as_uint(ps), __float_as_uint(ps), false, false); ps = __uint_as_float(rr[0]) + __uint_as_float(rr[1]); }
            l_reg += ps;
#define PK4(P, BASE, OUT) do { unsigned a0 = cvt_pk_bf16(P[BASE + 0], P[BASE + 1]), a1 = cvt_pk_bf16(P[BASE + 2], P[BASE + 3]);   \
    unsigned b0_ = cvt_pk_bf16(P[BASE + 4], P[BASE + 5]), b1_ = cvt_pk_bf16(P[BASE + 6], P[BASE + 7]);                              \
    auto r0 = __builtin_amdgcn_permlane32_swap(a0, b0_, false, false); auto r1 = __builtin_amdgcn_permlane32_swap(a1, b1_, false, false); \
    u32x4 w = {r0[0], r1[0], r0[1], r1[1]}; OUT = __builtin_bit_cast(bf16x8, w); } while (0)
            PK4(p0, 0, pa0); PK4(p0, 8, pa1); PK4(p1, 0, pa2); PK4(p1, 8, pa3);
#undef PK4
            if (!lag) pv_tile(o, vbase + vs_cur, pa0, pa1, pa2, pa3);
        }
        vs_prev = vs_cur; vs_cur = vs_next;
    }
    if (lag && NT - 1 < my_nt) pv_tile(o, vbase + vs_prev, pa0, pa1, pa2, pa3);
    if (hi == 0) wsf[32 + r32] = l_reg;
    asm volatile("s_waitcnt lgkmcnt(0)" ::: "memory");
    bf16_t* Yo = WSP(bf16_t, WS_Y) + (size_t)q0 * DM + LRUW + h * 128;
#pragma unroll
    for (int r = 0; r < 16; ++r) { const int orow = crow(r, hi); const float rl = __builtin_amdgcn_rcpf(wsf[32 + orow]);
#pragma unroll
        for (int d0 = 0; d0 < 4; ++d0) Yo[(size_t)orow * DM + d0 * 32 + r32] = (bf16_t)(cvt_pk_bf16(o[d0][r] * rl, 0.f) & 0xffffu); }
#undef ATT_DMA
#undef ATT_DMA1
}
__device__ __forceinline__ void attn_phase(Frame& F) {
    for (int uidx = F.vcu; uidx < 256; uidx += F.G) {
        const int h = uidx >> 4, s = uidx & 15;
        attn_unit(F, h, 31 - s);
        attn_unit(F, h, s);
    }
    asm volatile("s_waitcnt vmcnt(0) lgkmcnt(0)" ::: "memory"); __builtin_amdgcn_s_barrier();
}

__device__ __forceinline__ void p5_finalize(Frame& F) {
    LAS float* carry = (LAS float*)(F.lds + RING_OFF);
    const float* CA = WSP(float, WS_CA); const float* CH = WSP(float, WS_CH);
    const bf16_t* HL = WSP(bf16_t, WS_HLOC); const bf16_t* PPi = WSP(bf16_t, WS_PP); const bf16_t* PROJ = WSP(bf16_t, WS_PROJ);
    bf16_t* Y = WSP(bf16_t, WS_Y);
    const float* g_lru = INP(18); const float* g_mla = INP(19);
    for (int rb = F.vcu; rb < S_ / 32; rb += F.G) {
        const int chunk = rb >> 3;
        __syncthreads();
        { const int c4 = (F.wave * 64 + lane_id()) * 4; f32x4 st = (f32x4){0.f, 0.f, 0.f, 0.f};
          for (int c = 0; c < chunk; c += 8) {
              f32x4 a[8], hh[8];
#pragma unroll
              for (int i = 0; i < 8; ++i) { const int cc = (c + i < chunk) ? c + i : c; a[i] = *(const GAS f32x4*)((const GAS float*)CA + cc * LRUW + c4); hh[i] = *(const GAS f32x4*)((const GAS float*)CH + cc * LRUW + c4); }
#pragma unroll
              for (int i = 0; i < 8; ++i) if (c + i < chunk) st = a[i] * st + hh[i]; }
          *(LAS f32x4*)(carry + c4) = st; }
        __syncthreads();
        for (int rr = 0; rr < 4; rr += 2) {
            const int row0 = rb * 32 + F.wave * 4 + rr, ln = lane_id();
            u32x4 hl[2][4], pp[2][4], gr[2][4], ov[2][4];
#pragma unroll
            for (int q = 0; q < 2; ++q)
#pragma unroll
                for (int j = 0; j < 4; ++j) { const int c0 = 8 * (ln + 64 * j); const size_t row = (size_t)(row0 + q);
                    hl[q][j] = __builtin_nontemporal_load((const GAS u32x4*)((const GAS bf16_t*)HL + row * LRUW + c0)); pp[q][j] = __builtin_nontemporal_load((const GAS u32x4*)((const GAS bf16_t*)PPi + row * LRUW + c0));
                    gr[q][j] = __builtin_nontemporal_load((const GAS u32x4*)((const GAS bf16_t*)PROJ + row * NINP + COL_GR + c0)); ov[q][j] = __builtin_nontemporal_load((const GAS u32x4*)((const GAS bf16_t*)Y + row * DM + LRUW + c0)); }
#pragma unroll
            for (int q = 0; q < 2; ++q) {
                const size_t row = (size_t)(row0 + q);
                float y[4][8]; float ss = 0.f, s2 = 0.f;
#pragma unroll
                for (int j = 0; j < 4; ++j) { const int c0 = 8 * (ln + 64 * j);
                    const f32x4 ca = *(const LAS f32x4*)(carry + c0), cb = *(const LAS f32x4*)(carry + c0 + 4);
#pragma unroll
                    for (int e = 0; e < 4; ++e) { const float c_lo = (e < 2) ? ca[2 * e] : cb[2 * e - 4], c_hi = (e < 2) ? ca[2 * e + 1] : cb[2 * e - 3];
                        const float h0 = bflo(hl[q][j][e]) + bflo(pp[q][j][e]) * c_lo, h1 = bfhi(hl[q][j][e]) + bfhi(pp[q][j][e]) * c_hi;
                        const float y0 = h0 * gelu_tanh(bflo(gr[q][j][e])), y1 = h1 * gelu_tanh(bfhi(gr[q][j][e]));
                        y[j][2 * e] = y0; y[j][2 * e + 1] = y1; ss += y0 * y0 + y1 * y1;
                        const float a = bflo(ov[q][j][e]), b = bfhi(ov[q][j][e]); s2 += a * a + b * b; } }
                const float rstd = 1.0f / sqrtf(wave_sum(ss) * (1.0f / LRUW) + EPS), rstd2 = 1.0f / sqrtf(wave_sum(s2) * (1.0f / LRUW) + EPS);
#pragma unroll
                for (int j = 0; j < 4; ++j) { const int c0 = 8 * (ln + 64 * j); const f32x4 g0 = *(const f32x4*)(g_lru + c0), g1 = *(const f32x4*)(g_lru + c0 + 4), m0 = *(const f32x4*)(g_mla + c0), m1 = *(const f32x4*)(g_mla + c0 + 4);
                    u32x4 w; w.x = cvt_pk_bf16(y[j][0] * rstd * g0[0], y[j][1] * rstd * g0[1]); w.y = cvt_pk_bf16(y[j][2] * rstd * g0[2], y[j][3] * rstd * g0[3]);
                    w.z = cvt_pk_bf16(y[j][4] * rstd * g1[0], y[j][5] * rstd * g1[1]); w.w = cvt_pk_bf16(y[j][6] * rstd * g1[2], y[j][7] * rstd * g1[3]);
                    *(GAS u32x4*)((GAS bf16_t*)Y + row * DM + c0) = w;
                    u32x4 v; v.x = cvt_pk_bf16(bflo(ov[q][j][0]) * rstd2 * m0[0], bfhi(ov[q][j][0]) * rstd2 * m0[1]); v.y = cvt_pk_bf16(bflo(ov[q][j][1]) * rstd2 * m0[2], bfhi(ov[q][j][1]) * rstd2 * m0[3]);
                    v.z = cvt_pk_bf16(bflo(ov[q][j][2]) * rstd2 * m1[0], bfhi(ov[q][j][2]) * rstd2 * m1[1]); v.w = cvt_pk_bf16(bflo(ov[q][j][3]) * rstd2 * m1[2], bfhi(ov[q][j][3]) * rstd2 * m1[3]);
                    *(GAS u32x4*)((GAS bf16_t*)Y + row * DM + LRUW + c0) = v; }
            }
        }
    }
    __syncthreads();
}

__device__ __forceinline__ void p7_mid(Frame& F) {
    const float* MOD = WSP(float, WS_MOD);
    LAS float* cC = (LAS float*)(F.lds + RING_OFF); LAS float* cD = cC + DM; LAS float* cE = cD + DM;
    for (int ch = (F.wave * 64 + lane_id()); ch < DM; ch += NWAVES * 64) { cC[ch] = MOD[2 * DM + ch] * INP(21)[ch]; cD[ch] = INP(22)[ch] * (1.0f + MOD[4 * DM + ch]); cE[ch] = MOD[3 * DM + ch]; }
    __syncthreads();
    const int gw = F.vcu * NWAVES + F.wave, NGW = F.G * NWAVES;
    const bf16_t* YO = WSP(bf16_t, WS_YO); const float* xin = INP(0);
    for (int row = gw; row < S_; row += NGW) {
        u32x4 yv[8]; float s = 0.f;
#pragma unroll
        for (int j = 0; j < 8; ++j) { yv[j] = __builtin_nontemporal_load((const GAS u32x4*)((const GAS bf16_t*)YO + (size_t)row * DM + 8 * (lane_id() + 64 * j)));
#pragma unroll
            for (int e = 0; e < 4; ++e) { const float a = bflo(yv[j][e]), b = bfhi(yv[j][e]); s += a * a + b * b; } }
        const float rstd1 = 1.0f / sqrtf(wave_sum(s) * (1.0f / DM) + EPS);
        if (lane_id() == 0) WSP(float, WS_RS1)[row] = rstd1;
        f32x4 x1[8][2]; float s2 = 0.f;
#pragma unroll
        for (int j = 0; j < 8; ++j) { const int c0 = 8 * (lane_id() + 64 * j);
            const f32x4 xa = __builtin_nontemporal_load((const GAS f32x4*)(xin + (size_t)row * DM + c0)), xb = __builtin_nontemporal_load((const GAS f32x4*)(xin + (size_t)row * DM + c0 + 4));
            const f32x4 ca = *(const LAS f32x4*)(cC + c0), cb = *(const LAS f32x4*)(cC + c0 + 4);
            const f32x4 ya = (f32x4){bflo(yv[j][0]), bfhi(yv[j][0]), bflo(yv[j][1]), bfhi(yv[j][1])}, yb = (f32x4){bflo(yv[j][2]), bfhi(yv[j][2]), bflo(yv[j][3]), bfhi(yv[j][3])};
            const f32x4 a = xa + ca * ya * rstd1, b = xb + cb * yb * rstd1;
            x1[j][0] = a; x1[j][1] = b;
            s2 += (a[0] * a[0] + a[1] * a[1]) + (a[2] * a[2] + a[3] * a[3]) + (b[0] * b[0] + b[1] * b[1]) + (b[2] * b[2] + b[3] * b[3]); }
        const float rstd2 = 1.0f / sqrtf(wave_sum(s2) * (1.0f / DM) + EPS);
#pragma unroll
        for (int j = 0; j < 8; ++j) { const int c0 = 8 * (lane_id() + 64 * j);
            const f32x4 da = *(const LAS f32x4*)(cD + c0), db = *(const LAS f32x4*)(cD + c0 + 4), ea = *(const LAS f32x4*)(cE + c0), eb = *(const LAS f32x4*)(cE + c0 + 4);
            const f32x4 ha = x1[j][0] * rstd2 * da + ea, hb = x1[j][1] * rstd2 * db + eb;
            { const f32x4 a = x1[j][0], b = x1[j][1]; u32x4 w1; w1.x = cvt_pk_bf16(a[0], a[1]); w1.y = cvt_pk_bf16(a[2], a[3]); w1.z = cvt_pk_bf16(b[0], b[1]); w1.w = cvt_pk_bf16(b[2], b[3]); *(u32x4*)(WSP(bf16_t, WS_X1B) + (size_t)row * DM + c0) = w1; }
            u32x4 w; w.x = cvt_pk_bf16(ha[0], ha[1]); w.y = cvt_pk_bf16(ha[2], ha[3]); w.z = cvt_pk_bf16(hb[0], hb[1]); w.w = cvt_pk_bf16(hb[2], hb[3]);
            *(u32x4*)(WSP(bf16_t, WS_XN) + (size_t)row * DM + c0) = w; }
    }
    __syncthreads();
}

__device__ __forceinline__ void p10_final(Frame& F) {
    const float* MOD = WSP(float, WS_MOD);
    LAS float* cF = (LAS float*)(F.lds + RING_OFF);
    for (int ch = (F.wave * 64 + lane_id()); ch < DM; ch += NWAVES * 64) cF[ch] = MOD[5 * DM + ch] * INP(26)[ch];
    __syncthreads();
    const int gw = F.vcu * NWAVES + F.wave, NGW = F.G * NWAVES;
    const GAS bf16_t* FB = (const GAS bf16_t*)WSP(bf16_t, WS_F); const GAS bf16_t* X1 = (const GAS bf16_t*)WSP(bf16_t, WS_X1B);
    for (int row = gw; row < S_; row += NGW) {
        u32x4 fv[8]; float s = 0.f;
#pragma unroll
        for (int j = 0; j < 8; ++j) { fv[j] = __builtin_nontemporal_load((const GAS u32x4*)(FB + (size_t)row * DM + 8 * (lane_id() + 64 * j))); }
#pragma unroll
        for (int j = 0; j < 8; ++j) {
#pragma unroll
            for (int e = 0; e < 4; ++e) { const float a = bflo(fv[j][e]), b = bfhi(fv[j][e]); s += a * a + b * b; } }
        const float rstd = 1.0f / sqrtf(wave_sum(s) * (1.0f / DM) + EPS);
#pragma unroll
        for (int j = 0; j < 8; ++j) { const int c0 = 8 * (lane_id() + 64 * j);
            const f32x4 ca = *(const LAS f32x4*)(cF + c0), cb = *(const LAS f32x4*)(cF + c0 + 4);
            const f32x4 fa = (f32x4){bflo(fv[j][0]), bfhi(fv[j][0]), bflo(fv[j][1]), bfhi(fv[j][1])}, fb = (f32x4){bflo(fv[j][2]), bfhi(fv[j][2]), bflo(fv[j][3]), bfhi(fv[j][3])};
            const u32x4 xw = __builtin_nontemporal_load((const GAS u32x4*)(X1 + (size_t)row * DM + c0));
            const f32x4 x1a = (f32x4){bflo(xw[0]), bfhi(xw[0]), bflo(xw[1]), bfhi(xw[1])}, x1b = (f32x4){bflo(xw[2]), bfhi(xw[2]), bflo(xw[3]), bfhi(xw[3])};
            GAS float* op = (GAS float*)F.out + (size_t)row * DM + c0;
            __builtin_nontemporal_store(x1a + ca * fa * rstd, (GAS f32x4*)op); __builtin_nontemporal_store(x1b + cb * fb * rstd, (GAS f32x4*)(op + 4));
            if ((j & 3) == 3) __builtin_amdgcn_sched_barrier(0); }
    }
}

constexpr int NPH = 12;
struct Args { const float* in[27]; float* out; unsigned char* ws; int ph_lo, ph_hi, li, pad; };

template <class Epi, bool ALIGN>
__device__ __forceinline__ void run_gemm(Frame& F, const pg8::Gemm& g, const Epi& E) {
    pg8::StaticOrder S; S.init(g.M, g.N, F.G, (int)blockIdx.x);
    pg8::gemm_phase<Epi, pg8::StaticOrder, ALIGN>(F.lds + RING_OFF, g, S, E);
}

__global__ void __launch_bounds__(NWAVES * 64, 2) mk_fwd(Args args) {
    extern __shared__ __attribute__((aligned(16))) unsigned char lds_raw[];
    Frame F;
    F.lds = (LAS unsigned char*)lds_raw;
    F.wave = __builtin_amdgcn_readfirstlane((int)threadIdx.x >> 6);
    F.G = gridDim.x; { const int bx = blockIdx.x; F.vcu = (F.G % 8 == 0) ? (bx % 8) * (F.G / 8) + bx / 8 : bx; }
    F.out = args.out; F.ws = args.ws;
    unsigned* bar_region = (unsigned*)(F.ws + WS_CTL) + CW_BAR + args.li * 4096;
    XcdBarrier bar = xcd_barrier_post(bar_region, bar_region + XCD_BAR_WORDS + 2 * blockIdx.x);
#define GRID_BAR() xcd_barrier(bar)
    const int lo = args.ph_lo, hi = args.ph_hi;
#define IN(k) (lo <= (k) && (k) < hi)
#define BOTH(k) (IN(k) && IN((k) + 1))

    if (IN(0)) { p0a_prep(F); if (BOTH(0)) GRID_BAR(); }
    if (IN(1)) { p0b_xn(F); if (BOTH(1)) GRID_BAR(); }
    if (IN(2)) {
        pg8::Gemm g{WSP(bf16_t, WS_XN), WSP(bf16_t, WS_WIN), S_, NINP, DM, DM, DM};
        pg8::EpiStore E{WSP(bf16_t, WS_PROJ), NINP};
        run_gemm<pg8::EpiStore, true>(F, g, E);
        const int first = ((S_ / 256) * (NINP / 256)) % F.G;
        if ((int)blockIdx.x >= first) { LAS float* scr = (LAS float*)(F.lds + RING_OFF + F.wave * 16384); const int lw = ((int)blockIdx.x - first) * NWAVES + F.wave, nlw = (F.G - first) * NWAVES;
            const float* wsrc = INP(20); TR_RUN(tr_plain(wsrc, DM, WSP(bf16_t, WS_WOUT), DM, r), lw, nlw, 128 * (DM / 64), scr); }
        if (BOTH(2)) GRID_BAR();
    }
    if (IN(3)) { p2_thin(F); if (BOTH(3)) GRID_BAR(); }
    if (IN(4)) {
        { pg8::Gemm g{WSP(bf16_t, WS_PROJ) + COL_QL, WSP(bf16_t, WS_WQ), S_, NH * 192, QL, NINP, QL};
          pg8::EpiQ E{WSP(bf16_t, WS_QN), WSP(bf16_t, WS_QPE), WSP(float, WS_RSQ), WSP(f32x2, WS_CS)};
          run_gemm<pg8::EpiQ, true>(F, g, E);
          const int first = ((S_ / 256) * (NH * 192 / 256)) % F.G;
          if (first > 0 && (int)blockIdx.x >= first) { LAS float* scr = (LAS float*)(F.lds + RING_OFF + F.wave * 16384); const int lw = ((int)blockIdx.x - first) * NWAVES + F.wave, nlw = (F.G - first) * NWAVES;
              const float* wg = INP(23); const float* wu = INP(24); TR_RUN(wgu_item(wg, wu, WSP(bf16_t, WS_WGU), r, WGU_KB_P0A), lw, nlw, 688 * (64 - WGU_KB_P0A), scr); }
          else if (first == 0) { LAS float* scr = (LAS float*)(F.lds + RING_OFF + F.wave * 16384); const float* wg = INP(23); const float* wu = INP(24);
              TR_RUN(wgu_item(wg, wu, WSP(bf16_t, WS_WGU), r, WGU_KB_P0A), F.vcu * NWAVES + F.wave, F.G * NWAVES, 688 * (64 - WGU_KB_P0A), scr); }
          __syncthreads(); }
        { pg8::Gemm g{WSP(bf16_t, WS_PROJ) + COL_KVL, WSP(bf16_t, WS_WKV), S_, NH * 256, KVL, NINP, KVL};
          pg8::EpiKV E{WSP(bf16_t, WS_KT), WSP(bf16_t, WS_VT), WSP(float, WS_RSKV)};
          run_gemm<pg8::EpiKV, true>(F, g, E); }
        { const int gw = F.vcu * NWAVES + F.wave, NGW = F.G * NWAVES;
          for (int task = gw; task < 32 * 16 * 4; task += NGW) lru_task(F, task); }
        if (BOTH(4)) GRID_BAR();
    }
    if (IN(5)) { attn_phase(F); if (BOTH(5)) GRID_BAR(); }
    if (IN(6)) { p5_finalize(F); if (BOTH(6)) GRID_BAR(); }
    if (IN(7)) {
        pg8::Gemm g{WSP(bf16_t, WS_Y), WSP(bf16_t, WS_WOUT), S_, DM, DM, DM, DM};
        pg8::EpiStore E{WSP(bf16_t, WS_YO), DM};
        run_gemm<pg8::EpiStore, true>(F, g, E);
        if (BOTH(7)) GRID_BAR();
    }
    if (IN(8)) { p7_mid(F); if (BOTH(8)) GRID_BAR(); }
    if (IN(9)) {
        pg8::Gemm g{WSP(bf16_t, WS_XN), WSP(bf16_t, WS_WGU), S_, NGU, DM, DM, DM};
        pg8::EpiGU E{WSP(bf16_t, WS_H)};
        run_gemm<pg8::EpiGU, true>(F, g, E);
        const int first = ((S_ / 256) * (NGU / 256)) % F.G;
        if ((int)blockIdx.x >= first) { LAS float* scr = (LAS float*)(F.lds + RING_OFF + F.wave * 16384); const int lw = ((int)blockIdx.x - first) * NWAVES + F.wave, nlw = (F.G - first) * NWAVES;
            const float* wsrc = INP(25); TR_RUN(tr_plain(wsrc, DM, WSP(bf16_t, WS_WDN), DFF, r, WDN_KB_P0A), lw, nlw, 128 * (DFF / 64 - WDN_KB_P0A), scr); }
        if (BOTH(9)) GRID_BAR();
    }
    if (IN(10)) {
        pg8::Gemm g{WSP(bf16_t, WS_H), WSP(bf16_t, WS_WDN), S_, DM, DFF, DFF, DFF};
        pg8::EpiStore E{WSP(bf16_t, WS_F), DM};
        run_gemm<pg8::EpiStore, true>(F, g, E);
        if (BOTH(10)) GRID_BAR();
    }
    if (IN(11)) { p10_final(F); }
#undef IN
#undef BOTH
}

extern "C" void kernel_launch(void* const* d_in, const int* in_sizes, int n_in, void* d_out, int out_size, void* d_ws, size_t ws_size, hipStream_t stream) {
    static int grid = 0;
    if (grid == 0) {
        if (n_in != 27 || in_sizes[0] != S_ * DM || out_size != S_ * DM || ws_size < WS_END) {
            fprintf(stderr, "kernel_launch: unexpected shapes: n_in %d in0 %d out %d ws %zu (need >= %zu)\n", n_in, n_in > 0 ? in_sizes[0] : -1, out_size, ws_size, (size_t)WS_END); grid = -1; return; }
        int dev = 0, cus = 0, per_cu = 0;
        if (hipGetDevice(&dev) != hipSuccess || hipDeviceGetAttribute(&cus, hipDeviceAttributeMultiprocessorCount, dev) != hipSuccess) { grid = -1; return; }
        if (hipFuncSetAttribute((const void*)mk_fwd, hipFuncAttributeMaxDynamicSharedMemorySize, LDS_BYTES) != hipSuccess) { fprintf(stderr, "kernel_launch: hipFuncSetAttribute failed\n"); grid = -1; return; }
        if (hipOccupancyMaxActiveBlocksPerMultiprocessor(&per_cu, (const void*)mk_fwd, NWAVES * 64, LDS_BYTES) != hipSuccess || per_cu < 1)
            fprintf(stderr, "kernel_launch: note: occupancy query reports %d workgroups per CU\n", per_cu);
        (void)hipGetLastError();
        grid = cus;
    }
    if (grid < 0) return;
    (void)hipMemsetAsync((char*)d_ws + WS_CTL, 0, CTL_ZERO_BYTES, stream);
    (void)hipMemsetAsync((char*)d_ws + WS_WIN + (size_t)NIN * DM * 2, 0, (size_t)(NINP - NIN) * DM * 2, stream);
    Args a{};
    for (int i = 0; i < 27; ++i) a.in[i] = (const float*)d_in[i];
    a.out = (float*)d_out; a.ws = (unsigned char*)d_ws;
    static const int launch_list[][2] = { LAUNCH_LIST };
    constexpr int n_launch = (int)(sizeof(launch_list) / sizeof(launch_list[0]));
    static_assert(n_launch <= 32 && (CW_BAR + 32 * 4096) * 4 <= (int)CTL_ZERO_BYTES, "barrier regions");
    for (int li = 0; li < n_launch; ++li) {
        a.ph_lo = launch_list[li][0]; a.ph_hi = launch_list[li][1]; a.li = li; a.pad = 0;
        hipLaunchKernelGGL(mk_fwd, dim3(grid), dim3(NWAVES * 64), LDS_BYTES, stream, a);
        const hipError_t le = hipPeekAtLastError();
        if (le != hipSuccess) { fprintf(stderr, "kernel_launch: launch %d failed: %s\n", li, hipGetErrorName(le)); break; }
    }
}
```
